# Optimizing an MI355X kernel written in HIP

```python
import math
import jax
import jax.numpy as jnp
from jax import lax
import numpy as np

D_MODEL = 1024
BATCH = 8
SEQ = 2048
DEPTH = 2
DEC_BATCH = 128
DEC_SEQ = 4
PAST_LEN = 16384
PAGE_SIZE = 128

D_MIX = D_MODEL
HEAD_DIM = 64
A_HEADS = 6
B_HEADS = 6
C_HEADS = 4
A_WIDTH = A_HEADS * HEAD_DIM
B_WIDTH = B_HEADS * HEAD_DIM
C_WIDTH = C_HEADS * HEAD_DIM
A_DECAY_LORA = 32
A_AAA_LORA = 32
A_GATE_LORA = 64
A_COLS = 3 * A_WIDTH + A_DECAY_LORA + A_AAA_LORA + A_GATE_LORA
A_SPLITS = (A_WIDTH, 2 * A_WIDTH, 3 * A_WIDTH, 3 * A_WIDTH + A_DECAY_LORA, 3 * A_WIDTH + A_DECAY_LORA + A_AAA_LORA)
B_QKV = 3 * B_WIDTH
B_COLS = B_QKV + 2 * B_HEADS + B_WIDTH
C_COLS = 4 * C_WIDTH
IN_COLS = A_COLS + B_COLS + C_COLS
CONV_K = 4
CHUNK = 64
FF_HIDDEN = ((8 * D_MODEL // 3 + 255) // 256) * 256
N_ADA = 6
RMS_EPS = 1e-6
L2_EPS = 1e-6
GN_EPS = 64e-5

kernel_name = 'hybrid_rwkv7_gdn_hgrn2_adaln_step'


def rms_norm(x, w, eps=RMS_EPS):
    xf = x.astype(jnp.float32)
    y = xf * lax.rsqrt(jnp.mean(xf * xf, axis=-1, keepdims=True) + eps)
    return (y * w.astype(jnp.float32)).astype(x.dtype)


def l2_normalize(x, eps=L2_EPS):
    xf = x.astype(jnp.float32)
    return (xf * lax.rsqrt(jnp.sum(xf * xf, axis=-1, keepdims=True) + eps)).astype(x.dtype)


def group_norm_heads(y, w, b, eps=GN_EPS):
    B, T, H, D = y.shape
    mu = jnp.mean(y, axis=-1, keepdims=True)
    var = jnp.mean(jnp.square(y - mu), axis=-1, keepdims=True)
    yn = ((y - mu) * lax.rsqrt(var + eps)).reshape(B, T, H * D)
    return yn * w.astype(jnp.float32) + b.astype(jnp.float32)


def causal_depthwise_conv(x, buf, w):
    T = x.shape[1]
    xp = jnp.concatenate([buf.astype(x.dtype), x], axis=1)
    y = sum(xp[:, j:j + T] * w[j] for j in range(CONV_K))
    return y, xp[:, -(CONV_K - 1):]


def pad_time(a, C):
    pad = (-a.shape[1]) % C
    if pad == 0:
        return a
    widths = [(0, 0)] * a.ndim
    widths[1] = (0, pad)
    return jnp.pad(a, widths)


def to_chunks(a, C):
    B, Tp = a.shape[:2]
    a = a.reshape((B, Tp // C, C) + a.shape[2:])
    return jnp.swapaxes(jnp.swapaxes(a, 2, 3), 0, 1)


def from_chunks(o, T):
    N, B, H, C, D = o.shape
    return jnp.swapaxes(jnp.swapaxes(o, 0, 1), 2, 3).reshape(B, N * C, H, D)[:, :T]


def rwkv7_mixer(p_a, p_prev, S0, mu, w0, w2, a0, a2, g2, k_k, k_a, r_k, ln_w, ln_b):
    B, T, _ = p_a.shape
    f32 = jnp.float32
    prev = jnp.concatenate([p_prev.astype(p_a.dtype), p_a[:, :-1]], axis=1)
    xs = p_a + mu * (prev - p_a)
    r, k, v, xw, xa, xg = jnp.split(xs, A_SPLITS, axis=-1)
    w = -jax.nn.softplus(-(w0 + jnp.tanh(xw) @ w2)) - 0.5
    decay = jnp.exp(-jnp.exp(w.astype(f32)))
    a = jax.nn.sigmoid(a0 + xa @ a2)
    g = jax.nn.sigmoid(xg) @ g2
    hd = lambda t: t.reshape(B, T, A_HEADS, HEAD_DIM)
    kk = l2_normalize(hd(k * k_k))
    k = k * (1 + (a - 1) * k_a)
    r_h, k_h, v_h, a_h = hd(r), hd(k), hd(v), hd(a)
    seq = tuple(jnp.swapaxes(t.astype(f32), 0, 1) for t in (r_h, hd(decay), k_h, v_h, -kk, kk * a_h))

    def step(S, inp):
        rt, dt, kt, vt, at, bt = inp
        sa = jnp.einsum('bhvk,bhk->bhv', S, at)
        S = S * dt[:, :, None, :] + sa[..., None] * bt[:, :, None, :] + vt[..., None] * kt[:, :, None, :]
        return S, jnp.einsum('bhvk,bhk->bhv', S, rt)

    S, y = lax.scan(step, S0.astype(f32), seq)
    y = group_norm_heads(jnp.swapaxes(y, 0, 1), ln_w, ln_b)
    bonus = (jnp.sum(r_h * k_h * r_k, axis=-1, keepdims=True) * v_h).reshape(B, T, A_WIDTH)
    out = (y + bonus.astype(f32)) * g.astype(f32)
    return out.astype(p_a.dtype), S.astype(S0.dtype)


def gated_delta_chunked(q, k, v, g, beta, S0):
    T = q.shape[1]
    C = min(CHUNK, T)
    f32 = jnp.float32
    scale = q.shape[-1] ** -0.5
    qc, kc, vc, gc, bc = (to_chunks(pad_time(t, C), C) for t in
                          (q.astype(f32) * scale, k.astype(f32), v.astype(f32), g.astype(f32), beta.astype(f32)))
    gcum = jnp.cumsum(gc, axis=-1)
    tril = jnp.tril(jnp.ones((C, C), bool))
    strict = jnp.tril(jnp.ones((C, C), bool), -1)
    eye = jnp.eye(C, dtype=f32)
    diff = gcum[..., :, None] - gcum[..., None, :]
    decay = jnp.where(tril, jnp.exp(jnp.where(tril, diff, 0.0)), 0.0)
    kb = kc * bc[..., None]
    A = jnp.where(strict, jnp.einsum('nbhid,nbhjd->nbhij', kb, kc) * decay, 0.0)
    IA = A + eye
    u = lax.linalg.triangular_solve(IA, vc * bc[..., None], left_side=True, lower=True, unit_diagonal=True)
    w = lax.linalg.triangular_solve(IA, kb * jnp.exp(gcum)[..., None], left_side=True, lower=True, unit_diagonal=True)

    def step(S, inp):
        qi, ki, ui, wi, gi, di = inp
        v_new = ui - jnp.einsum('bhcd,bhde->bhce', wi, S)
        o_inter = jnp.einsum('bhcd,bhde->bhce', qi * jnp.exp(gi)[..., None], S)
        qk = jnp.einsum('bhid,bhjd->bhij', qi, ki) * di
        o = o_inter + jnp.einsum('bhij,bhje->bhie', qk, v_new)
        gl = gi[..., -1]
        S = S * jnp.exp(gl)[..., None, None] + jnp.einsum(
            'bhcd,bhce->bhde', ki * jnp.exp(gl[..., None] - gi)[..., None], v_new)
        return S, o

    S, o = lax.scan(step, S0.astype(f32), (qc, kc, u, w, gcum, decay))
    return from_chunks(o, T), S.astype(S0.dtype)


def gated_deltanet_mixer(p_b, conv_buf, S0, conv_w, A_log, dt_bias, norm_w):
    B, T, _ = p_b.shape
    f32 = jnp.float32
    qkv, beta_pre, a_pre, z = jnp.split(p_b, [B_QKV, B_QKV + B_HEADS, B_QKV + 2 * B_HEADS], axis=-1)
    qkv, new_buf = causal_depthwise_conv(qkv, conv_buf, conv_w)
    q, k, v = jnp.split(jax.nn.silu(qkv), 3, axis=-1)
    hd = lambda t: t.reshape(B, T, B_HEADS, HEAD_DIM)
    beta = jax.nn.sigmoid(beta_pre.astype(f32))
    g = -jnp.exp(A_log.astype(f32)) * jax.nn.softplus(a_pre.astype(f32) + dt_bias.astype(f32))
    o, S = gated_delta_chunked(l2_normalize(hd(q)), l2_normalize(hd(k)), hd(v), g, beta, S0)
    o = rms_norm(o, norm_w) * jax.nn.silu(hd(z)).astype(f32)
    return o.reshape(B, T, B_WIDTH).astype(p_b.dtype), new_buf, S


def hgrn2_chunked(q, k, v, logf, S0):
    T = q.shape[1]
    C = min(CHUNK, T)
    f32 = jnp.float32
    qc, kc, vc, fc = (to_chunks(pad_time(t.astype(f32), C), C) for t in (q, k, v, logf))
    bcum = jnp.cumsum(fc, axis=-2)
    tril = jnp.tril(jnp.ones((C, C), bool))[:, :, None]

    def step(S, inp):
        qi, ki, vi, bi = inp
        o_inter = jnp.einsum('bhtd,bhde->bhte', qi * jnp.exp(bi), S)
        diff = bi[:, :, :, None, :] - bi[:, :, None, :, :]
        dec = jnp.where(tril, jnp.exp(jnp.where(tril, diff, 0.0)), 0.0)
        A = jnp.einsum('bhtd,bhsd,bhtsd->bhts', qi, ki, dec)
        o = o_inter + jnp.einsum('bhts,bhse->bhte', A, vi)
        bl = bi[:, :, -1:, :]
        S = jnp.exp(bl[:, :, 0, :])[..., None] * S + jnp.einsum('bhsd,bhse->bhde', ki * jnp.exp(bl - bi), vi)
        return S, o

    S, o = lax.scan(step, S0.astype(f32), (qc, kc, vc, bcum))
    return from_chunks(o, T), S.astype(S0.dtype)


def hgrn2_mixer(p_c, S0, lb, norm_w):
    B, T, _ = p_c.shape
    f32 = jnp.float32
    q, f, i, z = jnp.split(p_c, 4, axis=-1)
    ff = f.astype(f32)
    logf = jnp.log(lb + (1.0 - lb) * jax.nn.sigmoid(ff))
    k = (1.0 - lb) * jax.nn.sigmoid(-ff)
    hd = lambda t: t.reshape(B, T, C_HEADS, HEAD_DIM)
    o, S = hgrn2_chunked(hd(jax.nn.silu(q)), hd(k), hd(i), hd(logf), S0)
    o = rms_norm(o, norm_w) * jax.nn.sigmoid(hd(z)).astype(f32)
    return o.reshape(B, T, C_WIDTH).astype(p_c.dtype), S


def trunk_layer(x, c_act, h_prev, S_a, conv_b, S_b, S_c,
                w_ada, b_ada, norm_mix_w, w_in,
                rwkv_mu, rwkv_w0, rwkv_w2, rwkv_a0, rwkv_a2, rwkv_g2, rwkv_k_k, rwkv_k_a, rwkv_r_k,
                rwkv_ln_w, rwkv_ln_b,
                gdn_conv_w, gdn_A_log, gdn_dt_bias, gdn_norm_w,
                lb, hgrn_norm_w,
                w_out, norm_ffn_w, w_ffn_in, w_ffn_out):
    mod = (c_act @ w_ada + b_ada)[:, None, :]
    shift_m, scale_m, gate_m, shift_f, scale_f, gate_f = jnp.split(mod, N_ADA, axis=-1)
    h = rms_norm(x, norm_mix_w) * (1 + scale_m) + shift_m
    p = h @ w_in
    p_a, p_b, p_c = jnp.split(p, [A_COLS, A_COLS + B_COLS], axis=-1)
    p_prev = (h_prev.astype(h.dtype) @ w_in[:, :A_COLS])[:, None, :]
    y_a, S_a = rwkv7_mixer(p_a, p_prev, S_a, rwkv_mu, rwkv_w0, rwkv_w2, rwkv_a0, rwkv_a2, rwkv_g2,
                           rwkv_k_k, rwkv_k_a, rwkv_r_k, rwkv_ln_w, rwkv_ln_b)
    y_b, conv_b, S_b = gated_deltanet_mixer(p_b, conv_b, S_b, gdn_conv_w, gdn_A_log, gdn_dt_bias, gdn_norm_w)
    y_c, S_c = hgrn2_mixer(p_c, S_c, lb, hgrn_norm_w)
    x = x + gate_m * (jnp.concatenate([y_a, y_b, y_c], axis=-1) @ w_out)
    h2 = rms_norm(x, norm_ffn_w) * (1 + scale_f) + shift_f
    gate, up = jnp.split(h2 @ w_ffn_in, 2, axis=-1)
    x = x + gate_f * ((jax.nn.silu(gate) * up) @ w_ffn_out)
    return x, (h[:, -1].astype(h_prev.dtype), S_a, conv_b.astype(h_prev.dtype), S_b, S_c)


def setup_inputs(seed: int = 0) -> dict:
    key = jax.random.key(seed)
    ks = jax.random.split(key, 36)
    f32 = jnp.float32
    L = DEPTH

    def nrm(i, shape, scale):
        return scale * jax.random.normal(ks[i], shape, f32)

    def uni(i, shape, lo, hi):
        return jax.random.uniform(ks[i], shape, f32, lo, hi)

    dt = jnp.exp(uni(27, (L, B_HEADS), math.log(1e-3), math.log(1e-1)))
    return {
        'x_prompt': nrm(0, (BATCH, SEQ, D_MODEL), 1.0),
        'x_sample': nrm(1, (DEC_BATCH, DEC_SEQ, D_MODEL), 1.0),
        'c_prompt': nrm(2, (BATCH, D_MODEL), 1.0),
        'c_sample': nrm(3, (DEC_BATCH, D_MODEL), 1.0),
        'state_rwkv_shift': nrm(4, (L, DEC_BATCH, D_MODEL), 1.0),
        'state_rwkv': nrm(5, (L, DEC_BATCH, A_HEADS, HEAD_DIM, HEAD_DIM), 0.5),
        'state_gdn_conv': nrm(6, (L, DEC_BATCH, CONV_K - 1, B_QKV), 1.0),
        'state_gdn': nrm(7, (L, DEC_BATCH, B_HEADS, HEAD_DIM, HEAD_DIM), 0.1),
        'state_hgrn': nrm(8, (L, DEC_BATCH, C_HEADS, HEAD_DIM, HEAD_DIM), 0.5),
        'w_ada': nrm(9, (L, D_MODEL, N_ADA * D_MODEL), 0.5 * D_MODEL ** -0.5),
        'b_ada': nrm(10, (L, N_ADA * D_MODEL), 0.01),
        'norm_mix_w': 1.0 + nrm(11, (L, D_MODEL), 0.05),
        'w_in': nrm(12, (L, D_MODEL, IN_COLS), D_MODEL ** -0.5),
        'rwkv_mu': uni(13, (L, A_COLS), 0.0, 1.0),
        'rwkv_w0': -1.0 + nrm(14, (L, A_WIDTH), 0.5),
        'rwkv_w2': nrm(15, (L, A_DECAY_LORA, A_WIDTH), A_DECAY_LORA ** -0.5),
        'rwkv_a0': nrm(16, (L, A_WIDTH), 0.1),
        'rwkv_a2': nrm(17, (L, A_AAA_LORA, A_WIDTH), A_AAA_LORA ** -0.5),
        'rwkv_g2': nrm(18, (L, A_GATE_LORA, A_WIDTH), A_GATE_LORA ** -0.5),
        'rwkv_k_k': 0.85 + nrm(19, (L, A_WIDTH), 0.05),
        'rwkv_k_a': 1.0 + nrm(20, (L, A_WIDTH), 0.05),
        'rwkv_r_k': nrm(21, (L, A_HEADS, HEAD_DIM), 0.1),
        'rwkv_ln_w': 1.0 + nrm(22, (L, A_WIDTH), 0.05),
        'rwkv_ln_b': nrm(23, (L, A_WIDTH), 0.01),
        'gdn_conv_w': nrm(24, (L, CONV_K, B_QKV), CONV_K ** -0.5),
        'gdn_A_log': jnp.log(uni(25, (L, B_HEADS), 1.0, 16.0)),
        'gdn_dt_bias': dt + jnp.log(-jnp.expm1(-dt)),
        'gdn_norm_w': 1.0 + nrm(26, (L, HEAD_DIM), 0.05),
        'hgrn_lb_logits': nrm(28, (L, C_WIDTH), 1.0),
        'hgrn_norm_w': 1.0 + nrm(29, (L, HEAD_DIM), 0.05),
        'w_out': nrm(30, (L, D_MIX, D_MODEL), D_MIX ** -0.5),
        'norm_ffn_w': 1.0 + nrm(31, (L, D_MODEL), 0.05),
        'w_ffn_in': nrm(32, (L, D_MODEL, 2 * FF_HIDDEN), D_MODEL ** -0.5),
        'w_ffn_out': nrm(33, (L, FF_HIDDEN, D_MODEL), FF_HIDDEN ** -0.5),
        'final_norm_w': 1.0 + nrm(34, (D_MODEL,), 0.05),
    }


def reference(x_prompt, x_sample, c_prompt, c_sample,
              state_rwkv_shift, state_rwkv, state_gdn_conv, state_gdn, state_hgrn,
              w_ada, b_ada, norm_mix_w, w_in,
              rwkv_mu, rwkv_w0, rwkv_w2, rwkv_a0, rwkv_a2, rwkv_g2, rwkv_k_k, rwkv_k_a, rwkv_r_k,
              rwkv_ln_w, rwkv_ln_b,
              gdn_conv_w, gdn_A_log, gdn_dt_bias, gdn_norm_w,
              hgrn_lb_logits, hgrn_norm_w,
              w_out, norm_ffn_w, w_ffn_in, w_ffn_out, final_norm_w):
    gam = jax.nn.softmax(hgrn_lb_logits.astype(jnp.float32), axis=0)
    lb_all = jnp.cumsum(gam, axis=0) - gam[0]

    def run_trunk(x, c, shift0, rwkv0, conv0, gdn0, hgrn0):
        c_act = jax.nn.silu(c)
        new = ([], [], [], [], [])
        for l in range(DEPTH):
            x, st = trunk_layer(
                x, c_act, shift0[l], rwkv0[l], conv0[l], gdn0[l], hgrn0[l],
                w_ada[l], b_ada[l], norm_mix_w[l], w_in[l],
                rwkv_mu[l], rwkv_w0[l], rwkv_w2[l], rwkv_a0[l], rwkv_a2[l], rwkv_g2[l],
                rwkv_k_k[l], rwkv_k_a[l], rwkv_r_k[l], rwkv_ln_w[l], rwkv_ln_b[l],
                gdn_conv_w[l], gdn_A_log[l], gdn_dt_bias[l], gdn_norm_w[l],
                lb_all[l], hgrn_norm_w[l],
                w_out[l], norm_ffn_w[l], w_ffn_in[l], w_ffn_out[l])
            for acc, s in zip(new, st):
                acc.append(s)
        y = rms_norm(x, final_norm_w)
        return y, [jnp.stack(acc) for acc in new]

    B = x_prompt.shape[0]
    y_prompt, (p_shift, p_rwkv, p_conv, p_gdn, p_hgrn) = run_trunk(
        x_prompt, c_prompt,
        jnp.zeros((DEPTH, B, D_MODEL), state_rwkv_shift.dtype),
        jnp.zeros((DEPTH, B, A_HEADS, HEAD_DIM, HEAD_DIM), state_rwkv.dtype),
        jnp.zeros((DEPTH, B, CONV_K - 1, B_QKV), state_gdn_conv.dtype),
        jnp.zeros((DEPTH, B, B_HEADS, HEAD_DIM, HEAD_DIM), state_gdn.dtype),
        jnp.zeros((DEPTH, B, C_HEADS, HEAD_DIM, HEAD_DIM), state_hgrn.dtype))
    y_sample, (s_shift, s_rwkv, s_conv, s_gdn, s_hgrn) = run_trunk(
        x_sample, c_sample, state_rwkv_shift, state_rwkv, state_gdn_conv, state_gdn, state_hgrn)
    return (y_prompt, y_sample, p_shift, p_rwkv, p_conv, p_gdn, p_hgrn, s_shift, s_rwkv, s_conv, s_gdn, s_hgrn)
```

```cpp
#include <hip/hip_runtime.h>
#include <cstdio>
#include <cstdint>
namespace pg8 {
#define PG8_LAS __attribute__((address_space(3)))
typedef unsigned short bf16_t;
typedef short bf16x8 __attribute__((ext_vector_type(8)));
typedef float f32x4 __attribute__((ext_vector_type(4)));
typedef unsigned u32x4 __attribute__((ext_vector_type(4)));
constexpr int BM = 256, BK = 64, HALF = 128, HTB = HALF * BK * 2  , STAGE_BYTES = 8 * HTB, NXCD = 8, WGM = 8;

__host__ __device__ __forceinline__ int lds_byte(int r, int c) { const int st = (r >> 4) * 2 + (c >> 5), rr = r & 15, cc = c & 31, ob = rr * 64 + cc * 2; return st * 1024 + (ob ^ (((ob >> 9) & 1) << 5)); }
__host__ __device__ __forceinline__ void stage_rc(int b, int& R, int& C) { const int st = b / 1024, sb = b % 1024, swz = sb ^ (((sb >> 9) & 1) << 5); R = (st >> 1) * 16 + swz / 64; C = (st & 1) * 32 + (swz % 64) / 2; }
__host__ __device__ __forceinline__ int perm32(int rho) { const int n = rho >> 4, i = rho & 15; return 8 * (i >> 2) + 4 * n + (i & 3); }

struct Unit { int pm, pn; };
struct Gemm { const bf16_t* A; const bf16_t* Bt; int M, N, K; };

struct StaticOrder {
    int nM, nN, nwg, G, c;
    __host__ __device__ void init(int M, int N, int G_, int c_) { nM = M / BM; nN = N / BM; nwg = nM * nN; G = G_; c = c_; }
    __host__ __device__ bool next(int i, Unit& u) const {
        const long L = (long)i * G + c; if (L >= nwg) return false;
        int wgid = (int)L; { const int q = nwg / NXCD, r = nwg % NXCD, xcd = wgid % NXCD, off = wgid / NXCD; wgid = (xcd < r ? xcd * (q + 1) : r * (q + 1) + (xcd - r) * q) + off; }
        const int nig = WGM * nN, gid = wgid / nig, fm = gid * WGM, gsz = (nM - fm) < WGM ? (nM - fm) : WGM;
        u.pm = fm + ((wgid % nig) % gsz); u.pn = (wgid % nig) / gsz; return true;
    }
    __device__ __forceinline__ void a_ready(const Unit&) const {}
    __device__ __forceinline__ void done(const Unit&) const {}
};

__device__ __forceinline__ unsigned cvt_pk_bf16(float lo, float hi) { unsigned r; asm volatile("v_cvt_pk_bf16_f32 %0, %1, %2" : "=v"(r) : "v"(lo), "v"(hi)); return r; }
typedef float f32x2 __attribute__((ext_vector_type(2)));

struct EpiBf16 {
    static constexpr bool PERM = true, AFTER_DRAIN = false;
    bf16_t* O; int ldc;
    __device__ __forceinline__ void operator()(const f32x4 (&acc)[2][2][4][2], const Unit& u, int wr, int wc, int fr, int fq) const {
        const int row0 = u.pm * BM + wr * 64 + fr; const int col0 = u.pn * BM + wc * 32 + 8 * fq;
#pragma unroll
        for (int ai = 0; ai < 2; ++ai)
#pragma unroll
            for (int m = 0; m < 4; ++m) { bf16_t* rowp = O + (size_t)(row0 + ai * HALF + m * 16) * ldc + col0;
#pragma unroll
                for (int bj = 0; bj < 2; ++bj) { const f32x4 v0 = acc[ai][bj][m][0], v1 = acc[ai][bj][m][1];
                    u32x4 w; w.x = cvt_pk_bf16(v0[0], v0[1]); w.y = cvt_pk_bf16(v0[2], v0[3]); w.z = cvt_pk_bf16(v1[0], v1[1]); w.w = cvt_pk_bf16(v1[2], v1[3]);
                    *(u32x4*)(rowp + bj * HALF) = w; } }
    }
};

struct EpiResid {
    static constexpr bool PERM = true, AFTER_DRAIN = false;
    const float* xin_p; const float* xin_s; float* xout; const float* gate;
    __device__ __forceinline__ void operator()(const f32x4 (&acc)[2][2][4][2], const Unit& u, int wr, int wc, int fr, int fq) const {
        const int row0 = u.pm * BM + wr * 64 + fr; const int col0 = u.pn * BM + wc * 32 + 8 * fq;
#pragma unroll
        for (int ai = 0; ai < 2; ++ai)
#pragma unroll
            for (int m = 0; m < 4; ++m) {
                const int row = row0 + ai * HALF + m * 16;
                const int seq = row < 16384 ? (row >> 11) : 8 + ((row - 16384) >> 2);
                const float* xi = (row < 16384 ? xin_p + (size_t)row * 1024 : xin_s + (size_t)(row - 16384) * 1024) + col0;
                const float* g = gate + (size_t)seq * 6144 + col0;
                float* xo = xout + (size_t)row * 1024 + col0;
#pragma unroll
                for (int bj = 0; bj < 2; ++bj) {
                    const f32x4 x0 = *(const f32x4*)(xi + bj * HALF), x1 = *(const f32x4*)(xi + bj * HALF + 4);
                    const f32x4 g0 = *(const f32x4*)(g + bj * HALF), g1 = *(const f32x4*)(g + bj * HALF + 4);
                    *(f32x4*)(xo + bj * HALF) = x0 + g0 * acc[ai][bj][m][0];
                    *(f32x4*)(xo + bj * HALF + 4) = x1 + g1 * acc[ai][bj][m][1]; } }
    }
};

struct EpiSwiGLU {
    static constexpr bool PERM = true, AFTER_DRAIN = false;
    bf16_t* O; int ldc;
    __device__ __forceinline__ void operator()(const f32x4 (&acc)[2][2][4][2], const Unit& u, int wr, int wc, int fr, int fq) const {
        const int row0 = u.pm * BM + wr * 64 + fr; const int col0 = u.pn * HALF + wc * 32 + 8 * fq;
#pragma unroll
        for (int ai = 0; ai < 2; ++ai)
#pragma unroll
            for (int m = 0; m < 4; ++m) { bf16_t* rowp = O + (size_t)(row0 + ai * HALF + m * 16) * ldc + col0;
                float r[8];
#pragma unroll
                for (int n = 0; n < 2; ++n)
#pragma unroll
                    for (int e = 0; e < 4; ++e) { const float gt = acc[ai][0][m][n][e], up = acc[ai][1][m][n][e];
                        r[n * 4 + e] = gt * __builtin_amdgcn_rcpf(1.f + __builtin_amdgcn_exp2f(-1.44269504089f * gt)) * up; }
                u32x4 w; w.x = cvt_pk_bf16(r[0], r[1]); w.y = cvt_pk_bf16(r[2], r[3]); w.z = cvt_pk_bf16(r[4], r[5]); w.w = cvt_pk_bf16(r[6], r[7]);
                *(u32x4*)rowp = w; }
    }
};

struct EpiAny {
    static constexpr bool PERM = true, AFTER_DRAIN = false;
    int mode; bf16_t* O; int ldc; const float* xin_p; const float* xin_s; float* xout; const float* gate;
    __device__ __forceinline__ void operator()(const f32x4 (&acc)[2][2][4][2], const Unit& u, int wr, int wc, int fr, int fq) const {
        if (mode == 0) { EpiBf16 e{O, ldc}; e(acc, u, wr, wc, fr, fq); }
        else if (mode == 1) { EpiResid e{xin_p, xin_s, xout, gate}; e(acc, u, wr, wc, fr, fq); }
        else { EpiSwiGLU e{O, ldc}; e(acc, u, wr, wc, fr, fq); }
    }
};

template <class Epi, class Sched, bool ALIGN_EPI = false, bool SP2 = false>
__device__ __forceinline__ void gemm_phase(PG8_LAS unsigned char* lds, const Gemm g, const Sched& S, const Epi& E, const int tid) {
    const int wid = __builtin_amdgcn_readfirstlane(tid >> 6), lane = tid & 63, wr = wid >> 2, wc = wid & 3, fr = lane & 15, fq = lane >> 4;
    const int K = g.K, nt = K / BK;
    unsigned voffA[2], voffB[2];
#pragma unroll
    for (int i = 0; i < 2; ++i) { int R, C; stage_rc(tid * 16 + i * 8192, R, C); const int Rb = Epi::PERM ? ((R & ~31) + perm32(R & 31)) : R;
        voffA[i] = (unsigned)(R * K + C) * 2u; voffB[i] = (unsigned)(Rb * K + C) * 2u; }
    const size_t kstep = (size_t)(BK * 2);
    const size_t hstep = (size_t)HALF * K * 2;
    const size_t tstep = 2 * hstep;
    const unsigned ldsw = (unsigned)wid * 1024u;
    const int aoff = lds_byte(wr * 64 + fr, fq * 8), boff = lds_byte(wc * 32 + fr, fq * 8);
#define PG8_SA(b, h) (((b) * 2 + (h)) * HTB)
#define PG8_SB(b, h) ((4 + (b) * 2 + (h)) * HTB)
#define PG8_STAGE(bufoff, gbase, voff) do { _Pragma("unroll") for (int _i = 0; _i < 2; ++_i) \
        __builtin_amdgcn_global_load_lds((const unsigned*)((const char*)(gbase) + (voff)[_i]), (PG8_LAS unsigned*)(lds + (bufoff) + ldsw + _i * 8192), 16, 0, 0); } while (0)
#define PG8_LDA(dst, b, h) do { _Pragma("unroll") for (int m = 0; m < 4; ++m) _Pragma("unroll") for (int k = 0; k < 2; ++k) dst[m][k] = *(const PG8_LAS bf16x8*)(lds + PG8_SA(b, h) + aoff + m * 2048 + k * 1024); } while (0)
#define PG8_LDB(dst, b, h) do { _Pragma("unroll") for (int n = 0; n < 2; ++n) _Pragma("unroll") for (int k = 0; k < 2; ++k) dst[n][k] = *(const PG8_LAS bf16x8*)(lds + PG8_SB(b, h) + boff + n * 2048 + k * 1024); } while (0)
#define PG8_MMA(ai, bj, At, Bt) do { __builtin_amdgcn_s_setprio(1); _Pragma("unroll") for (int m = 0; m < 4; ++m) _Pragma("unroll") for (int n = 0; n < 2; ++n) _Pragma("unroll") for (int k = 0; k < 2; ++k) \
        acc[ai][bj][m][n] = __builtin_amdgcn_mfma_f32_16x16x32_bf16(Bt[n][k], At[m][k], acc[ai][bj][m][n], 0, 0, 0); __builtin_amdgcn_s_setprio(0); } while (0)
#define PG8_WAIT_V(n) asm volatile("s_waitcnt vmcnt(" #n ")" ::: "memory")
#define PG8_WAIT_L(n) asm volatile("s_waitcnt lgkmcnt(" #n ")" ::: "memory")
#define PG8_BAR __builtin_amdgcn_s_barrier()
#define PG8_SCHED __builtin_amdgcn_sched_barrier(0)
    Unit cur, nxt; int ui = 0;
    if (!S.next(0, cur)) return;
    f32x4 acc[2][2][4][2];
#pragma unroll
    for (int a = 0; a < 2; ++a)
#pragma unroll
        for (int b = 0; b < 2; ++b)
#pragma unroll
            for (int m = 0; m < 4; ++m)
#pragma unroll
                for (int n = 0; n < 2; ++n) acc[a][b][m][n] = (f32x4){0.f, 0.f, 0.f, 0.f};
    bf16x8 At[4][2], B0[2][2], B1[2][2];
    const char* cA = (const char*)g.A + (size_t)cur.pm * tstep; const char* cB = (const char*)g.Bt + (size_t)cur.pn * tstep;
    S.a_ready(cur);
    if constexpr (SP2) {
        PG8_STAGE(PG8_SB(0, 0), cB, voffB); PG8_STAGE(PG8_SB(0, 1), cB + hstep, voffB); PG8_STAGE(PG8_SA(0, 0), cA, voffA); PG8_STAGE(PG8_SA(0, 1), cA + hstep, voffA);
        if (wr == 1) PG8_BAR;
        PG8_WAIT_V(2); PG8_BAR;
        PG8_STAGE(PG8_SB(1, 0), cB + kstep, voffB); PG8_STAGE(PG8_SA(1, 0), cA + kstep, voffA); PG8_STAGE(PG8_SB(1, 1), cB + hstep + kstep, voffB);
        PG8_WAIT_V(6); PG8_BAR;
    } else {
        PG8_STAGE(PG8_SB(0, 0), cB, voffB); PG8_STAGE(PG8_SA(0, 0), cA, voffA); PG8_STAGE(PG8_SB(0, 1), cB + hstep, voffB); PG8_STAGE(PG8_SA(0, 1), cA + hstep, voffA);
        if (wr == 1) PG8_BAR;
        PG8_WAIT_V(4); PG8_BAR;
        PG8_STAGE(PG8_SB(1, 0), cB + kstep, voffB); PG8_STAGE(PG8_SA(1, 0), cA + kstep, voffA); PG8_STAGE(PG8_SB(1, 1), cB + hstep + kstep, voffB);
        PG8_WAIT_V(6); PG8_BAR;
    }
    for (;;) {
        const bool has_next = S.next(ui + 1, nxt);
        const char* nA = has_next ? (const char*)g.A + (size_t)nxt.pm * tstep : cA; const char* nB = has_next ? (const char*)g.Bt + (size_t)nxt.pn * tstep : cB;
        for (int t = 0; t < nt; t += 2) {
            const bool last = (t == nt - 2);
            const char* a1 = cA + (size_t)(t + 1) * kstep;
            const char* a2 = last ? nA : cA + (size_t)(t + 2) * kstep; const char* b2 = last ? nB : cB + (size_t)(t + 2) * kstep;
            const char* a3 = a2 + kstep; const char* b3 = b2 + kstep;
            if (last && has_next) S.a_ready(nxt);
            if constexpr (SP2) {
            PG8_LDB(B0, 0, 0); PG8_LDB(B1, 0, 1); PG8_SCHED; PG8_LDA(At, 0, 0); PG8_STAGE(PG8_SA(1, 1), a1 + hstep, voffA);
            PG8_WAIT_V(8); PG8_WAIT_L(0); PG8_BAR; PG8_MMA(0, 0, At, B0); PG8_MMA(0, 1, At, B1); PG8_BAR; PG8_SCHED;
            PG8_LDA(At, 0, 1); PG8_STAGE(PG8_SB(0, 0), b2, voffB); PG8_STAGE(PG8_SB(0, 1), b2 + hstep, voffB); PG8_STAGE(PG8_SA(0, 0), a2, voffA);
            PG8_WAIT_V(8); PG8_WAIT_L(0); PG8_BAR; PG8_MMA(1, 0, At, B0); PG8_MMA(1, 1, At, B1); PG8_BAR; PG8_SCHED;
            PG8_LDB(B0, 1, 0); PG8_LDB(B1, 1, 1); PG8_SCHED; PG8_LDA(At, 1, 0); PG8_STAGE(PG8_SA(0, 1), a2 + hstep, voffA);
            PG8_WAIT_V(8); PG8_WAIT_L(0); PG8_BAR; PG8_MMA(0, 0, At, B0); PG8_MMA(0, 1, At, B1); PG8_BAR; PG8_SCHED;
            PG8_LDA(At, 1, 1); PG8_STAGE(PG8_SB(1, 0), b3, voffB); PG8_STAGE(PG8_SB(1, 1), b3 + hstep, voffB); PG8_STAGE(PG8_SA(1, 0), a3, voffA);
            PG8_WAIT_V(8); PG8_WAIT_L(0); PG8_BAR; PG8_MMA(1, 0, At, B0); PG8_MMA(1, 1, At, B1); PG8_BAR; PG8_SCHED;
            } else {
            PG8_LDB(B0, 0, 0); PG8_SCHED; PG8_LDA(At, 0, 0); PG8_STAGE(PG8_SA(1, 1), a1 + hstep, voffA);
            PG8_WAIT_L(8); PG8_BAR; PG8_WAIT_L(0); PG8_MMA(0, 0, At, B0); PG8_BAR; PG8_SCHED;
            PG8_LDB(B1, 0, 1); PG8_STAGE(PG8_SB(0, 0), b2, voffB);
            PG8_BAR; PG8_WAIT_L(0); PG8_MMA(0, 1, At, B1); PG8_BAR;
            PG8_LDA(At, 0, 1); PG8_STAGE(PG8_SA(0, 0), a2, voffA);
            PG8_BAR; PG8_WAIT_L(0); PG8_MMA(1, 0, At, B0); PG8_BAR; PG8_SCHED;
            PG8_STAGE(PG8_SB(0, 1), b2 + hstep, voffB);
            PG8_WAIT_V(6); PG8_BAR; PG8_MMA(1, 1, At, B1); PG8_BAR;
            PG8_LDB(B0, 1, 0); PG8_SCHED; PG8_LDA(At, 1, 0); PG8_STAGE(PG8_SA(0, 1), a2 + hstep, voffA);
            PG8_WAIT_L(8); PG8_BAR; PG8_WAIT_L(0); PG8_MMA(0, 0, At, B0); PG8_BAR; PG8_SCHED;
            PG8_LDB(B1, 1, 1); PG8_STAGE(PG8_SB(1, 0), b3, voffB);
            PG8_BAR; PG8_WAIT_L(0); PG8_MMA(0, 1, At, B1); PG8_BAR;
            PG8_LDA(At, 1, 1); PG8_STAGE(PG8_SA(1, 0), a3, voffA);
            PG8_BAR; PG8_WAIT_L(0); PG8_MMA(1, 0, At, B0); PG8_BAR; PG8_SCHED;
            PG8_STAGE(PG8_SB(1, 1), b3 + hstep, voffB);
            PG8_WAIT_V(6); PG8_BAR; PG8_MMA(1, 1, At, B1); PG8_BAR;
            }
        }
        if constexpr (ALIGN_EPI) { if (wr == 0) PG8_BAR; }
        if constexpr (!Epi::AFTER_DRAIN) { E(acc, cur, wr, wc, fr, fq); S.done(cur); }
        if (!has_next) break;
#pragma unroll
        for (int a = 0; a < 2; ++a)
#pragma unroll
            for (int b = 0; b < 2; ++b)
#pragma unroll
                for (int m = 0; m < 4; ++m)
#pragma unroll
                    for (int n = 0; n < 2; ++n) acc[a][b][m][n] = (f32x4){0.f, 0.f, 0.f, 0.f};
        cur = nxt; cA = nA; cB = nB; ++ui;
        if constexpr (ALIGN_EPI) { if (wr == 1) PG8_BAR; }
    }
    PG8_WAIT_V(0);
    if constexpr (!ALIGN_EPI) { if (wr == 0) PG8_BAR; }
    PG8_BAR;
    if constexpr (Epi::AFTER_DRAIN) { E.fused(acc, cur, wr, wc, fr, fq, lds, wid, lane); S.done(cur); }
#undef PG8_SA
#undef PG8_SB
#undef PG8_STAGE
#undef PG8_LDA
#undef PG8_LDB
#undef PG8_MMA
#undef PG8_WAIT_V
#undef PG8_WAIT_L
#undef PG8_BAR
#undef PG8_SCHED
}
}

#define GAS __attribute__((address_space(1)))
#define LAS __attribute__((address_space(3)))
typedef unsigned short bf16;
typedef unsigned v4u __attribute__((ext_vector_type(4)));
typedef float f32x4 __attribute__((ext_vector_type(4)));
typedef short bf16x8 __attribute__((ext_vector_type(8)));
typedef GAS unsigned gu32;
typedef GAS unsigned long long gu64;
#define RLX_AGENT __ATOMIC_RELAXED, __HIP_MEMORY_SCOPE_AGENT
#define LDS_WAIT() asm volatile("s_waitcnt lgkmcnt(0)" ::: "memory")
#define VM_WAIT() asm volatile("s_waitcnt vmcnt(0)" ::: "memory")
__device__ __forceinline__ unsigned long long rt() { return __builtin_amdgcn_s_memrealtime(); }
__device__ __forceinline__ unsigned f2bf(float f) { unsigned u = __builtin_bit_cast(unsigned, f); return (u + 0x7fffu + ((u >> 16) & 1u)) >> 16; }
__device__ __forceinline__ unsigned pk2(float lo, float hi) { return f2bf(lo) | (f2bf(hi) << 16); }

#define XB_TMO      128
#define XB_XCNT(j)  (256  + 64 * (j))
#define XB_XSUB(j)  (1280 + 64 * (j))
#define XB_XGEN(j)  (2304 + 64 * (j))
#define XB_TOP      3328
#define XB_TOPGEN   3392
#define XCD_BAR_WORDS 3456
#define XB_SPIN_CAP (1u << 18)

__device__ __forceinline__ unsigned xb_ld(unsigned* p)              { return __hip_atomic_load(p, __ATOMIC_RELAXED, __HIP_MEMORY_SCOPE_AGENT); }
__device__ __forceinline__ unsigned xb_add(unsigned* p, unsigned v) { return __hip_atomic_fetch_add(p, v, __ATOMIC_RELAXED, __HIP_MEMORY_SCOPE_AGENT); }
__device__ __forceinline__ unsigned xb_xcc_id() { return (unsigned)__builtin_amdgcn_s_getreg((3 << 11) | 20) & 0xFu; }
#define XB_SPIN(cond, bar) do { unsigned _sp = 0; while (cond) { __builtin_amdgcn_s_sleep(1); \
    if ((++_sp & 255u) == 0u) { if (xb_ld(&(bar)[XB_TMO])) break; if (_sp > XB_SPIN_CAP) { atomicAdd(&(bar)[XB_TMO], 1u); break; } } } } while (0)

struct XcdBarrier {
    unsigned* bar; unsigned x;
    volatile LAS unsigned* st;
};

__device__ __forceinline__ XcdBarrier xcd_barrier_post(unsigned* bar, volatile LAS unsigned* st) {
    XcdBarrier b; b.bar = bar; b.x = xb_xcc_id(); b.st = st;
    if (threadIdx.x == 0) (void)xb_add(&bar[XB_XCNT(b.x)], 1u);
    return b;
}
__device__ __forceinline__ void xcd_barrier_complete(unsigned* bar, unsigned x, unsigned& nloc, unsigned& nx) {
    const unsigned G = gridDim.x * gridDim.y * gridDim.z;
    unsigned sum, cnt, mine, sp = 0u;
    for (;;) {
        sum = 0u; cnt = 0u; mine = 0u;
#pragma unroll
        for (unsigned j = 0; j < 16; ++j) { const unsigned c = xb_ld(&bar[XB_XCNT(j)]); sum += c; cnt += (c > 0u) ? 1u : 0u; mine = (j == x) ? c : mine; }
        if (sum == G) break;
        __builtin_amdgcn_s_sleep(1);
        if ((++sp & 255u) == 0u) { if (xb_ld(&bar[XB_TMO])) break; if (sp > XB_SPIN_CAP) { atomicAdd(&bar[XB_TMO], 1u); break; } }
    }
    nloc = mine > 0u ? mine : 1u; nx = cnt > 0u ? cnt : 1u;
}

__device__ __forceinline__ void xcd_barrier(const XcdBarrier& b) {
    asm volatile("s_waitcnt vmcnt(0)" ::: "memory");
    __syncthreads();
    if (threadIdx.x == 0) {
        unsigned* bar = b.bar;
        __builtin_amdgcn_s_waitcnt(0);
        unsigned nloc = b.st[0], nx = b.st[1];
        if (nloc == 0u) { xcd_barrier_complete(bar, b.x, nloc, nx); b.st[0] = nloc; b.st[1] = nx; }
        const unsigned old = xb_add(&bar[XB_XSUB(b.x)], 1u);
        const unsigned gen = old / nloc;
        if (old + 1u == (gen + 1u) * nloc) {
            __builtin_amdgcn_fence(__ATOMIC_RELEASE, "agent");
            asm volatile("s_waitcnt vmcnt(0)" ::: "memory");
            const unsigned og = xb_add(&bar[XB_TOP], 1u);
            const unsigned tg = og / nx;
            if (og + 1u == (tg + 1u) * nx) xb_add(&bar[XB_TOPGEN], 1u);
            else XB_SPIN(xb_ld(&bar[XB_TOPGEN]) == tg, bar);
            __builtin_amdgcn_fence(__ATOMIC_ACQUIRE, "agent");
            xb_add(&bar[XB_XGEN(b.x)], 1u);
            asm volatile("s_waitcnt vmcnt(0)" ::: "memory");
        } else {
            XB_SPIN(xb_ld(&bar[XB_XGEN(b.x)]) == gen, bar);
            __builtin_amdgcn_fence(__ATOMIC_ACQUIRE, "agent");
            asm volatile("s_waitcnt vmcnt(0)" ::: "memory");
        }
    }
    __syncthreads();
}

constexpr int NWAVES = 8;
#ifndef MK_N_LAUNCHES
#define MK_N_LAUNCHES 16
#endif
constexpr int NPHASES = 16;

constexpr int D = 1024, NSEQ = 136, MPR = 16384, M = 16896, MEXT = 17024, MPAD = 17152;
constexpr int NIN = 4096;
constexpr int FF = 2816, NFI = 5632, NMOD = 6144, DEPTH = 2;
constexpr int P_GQKV = 1280, P_GZ = 2432, P_H = 2816, P_BETA = 3840, P_APRE = 3846;
constexpr size_t O_PSHIFT = 17301504, O_PRWKV = 17317888, O_PCONV = 17711104, O_PGDN = 17766400, O_PHGRN = 18159616,
                 O_SSHIFT = 18421760, O_SRWKV = 18683904, O_SCONV = 24975360, O_SGDN = 25860096, O_SHGRN = 32151552, O_TOTAL = 36345856;
constexpr size_t MiB = 1u << 20;
constexpr size_t WS_CTL = 0, CTL_ZERO_BYTES = 64 * 1024;
constexpr size_t WS_MOD = 1 * MiB;
constexpr size_t WS_WIN = 8 * MiB;
constexpr size_t WS_WOUT = 24 * MiB;
constexpr size_t WS_WFI = 28 * MiB;
constexpr size_t WS_WFO = 50 * MiB;
constexpr size_t WS_HB = 62 * MiB;
constexpr size_t WS_P = 96 * MiB;
constexpr size_t WS_END = 230 * MiB;
static_assert(WS_MOD + (size_t)DEPTH * NSEQ * NMOD * 4 <= WS_WIN && WS_WIN + (size_t)DEPTH * NIN * D * 2 <= WS_WOUT && WS_WOUT + (size_t)DEPTH * D * D * 2 <= WS_WFI &&
              WS_WFI + (size_t)DEPTH * NFI * D * 2 <= WS_WFO && WS_WFO + (size_t)DEPTH * D * FF * 2 <= WS_HB && WS_HB + (size_t)MPAD * D * 2 <= WS_P && WS_P + (size_t)MPAD * NIN * 2 <= WS_END, "ws map");
constexpr int CW_BAR = 4096;
constexpr int RING_BYTES = 131072, LDSCTL_OFF = RING_BYTES, MISC_OFF = LDSCTL_OFF + 320, LDS_BYTES = 147456;

typedef LAS float lf32;
struct Args { const float* in[35]; float* out; unsigned char* ws; int ph_lo, ph_hi; };
#define INP(i) (A.in[i])
struct Frame {
    LAS unsigned char* lds;
    volatile LAS unsigned* MISC;
    gu32* ctl;
    int tid, lane, wave, G, bid;
    float* out;
    float* mod; bf16 *win_t, *wout_t, *wfi_t, *wfo_t, *hb, *p;
};
enum { I_XP = 0, I_XS, I_CP, I_CS, I_SSHIFT, I_SRWKV, I_SCONV, I_SGDN, I_SHGRN, I_WADA, I_BADA, I_NMW, I_WIN, I_MU, I_W0, I_W2, I_A0, I_A2, I_G2, I_KK, I_KA, I_RK, I_LNW, I_LNB,
       I_CONVW, I_ALOG, I_DTB, I_GNW, I_LBL, I_HNW, I_WOUT, I_NFW, I_WFI, I_WFO, I_FNW };

__device__ __forceinline__ float wave_sum(float v) {
#pragma unroll
    for (int o = 1; o < 64; o <<= 1) v += __shfl_xor(v, o);
    return v;
}
template <int CTRL> __device__ __forceinline__ float dpp_mov(float x) { return __builtin_bit_cast(float, __builtin_amdgcn_mov_dpp(__builtin_bit_cast(int, x), CTRL, 0xF, 0xF, true)); }
__device__ __forceinline__ float red8(float x) {
    x += dpp_mov<0xB1>(x);
    x += dpp_mov<0x4E>(x);
    x += dpp_mov<0x141>(x);
    return x;
}
__device__ __forceinline__ float bf2f(bf16 u) { return __builtin_bit_cast(float, (unsigned)u << 16); }
__device__ __forceinline__ float sigmoidf_(float x) { return 1.f / (1.f + __expf(-x)); }
__device__ __forceinline__ float siluf_(float x) { return x / (1.f + __expf(-x)); }
__device__ __forceinline__ float softplusf_(float x) { return fmaxf(x, 0.f) + log1pf(__expf(-fabsf(x))); }
__device__ __forceinline__ int seq_of_row(int row) { return row < MPR ? (row >> 11) : 8 + ((row - MPR) >> 2); }

__device__ __forceinline__ void transpose_item(const float* W, int ldw, int K, int k0, int src_c0, int ncv, bf16* WT, int dst_r0, lf32* scr, int lane) {
    const int c = lane & 31;
#pragma unroll 8
    for (int i = 0; i < 32; ++i) { const int kk = 2 * i + (lane >> 5); scr[kk * 33 + c] = (c < ncv) ? W[(size_t)(k0 + kk) * ldw + src_c0 + c] : 0.f; }
    LDS_WAIT(); asm volatile("" ::: "memory");
    const int c8 = lane & 7;
#pragma unroll
    for (int j = 0; j < 4; ++j) { const int n = (lane >> 3) + 8 * j; const lf32* s = scr + (8 * c8) * 33 + n;
        v4u o; o.x = pk2(s[0 * 33], s[1 * 33]); o.y = pk2(s[2 * 33], s[3 * 33]); o.z = pk2(s[4 * 33], s[5 * 33]); o.w = pk2(s[6 * 33], s[7 * 33]);
        if (n < ncv) *(GAS v4u*)(WT + (size_t)(dst_r0 + n) * K + k0 + 8 * c8) = o; }
    LDS_WAIT(); asm volatile("" ::: "memory");
}

__device__ __forceinline__ void p0_prologue(const Args& A, Frame& F) {
    {
        lf32* cact = (lf32*)F.lds;
        for (int wb = F.bid; wb < 256; wb += F.G) {
            const int l = wb >> 7, n0 = (wb & 127) * 48;
            const int ncol = n0 + (F.lane < 48 ? F.lane : 47);
            const float* Wl = INP(I_WADA) + (size_t)l * D * NMOD + ncol;
            float acc[17];
#pragma unroll
            for (int j = 0; j < 17; ++j) acc[j] = 0.f;
            for (int kc = 0; kc < 16; ++kc) {
                __syncthreads();
#pragma unroll
                for (int i = 0; i < 17; ++i) { const int idx = F.tid + 512 * i; const int s = idx >> 6, kk = idx & 63;
                    const float cv = s < 8 ? INP(I_CP)[s * D + kc * 64 + kk] : INP(I_CS)[(s - 8) * D + kc * 64 + kk];
                    cact[idx] = siluf_(cv); }
                __syncthreads();
#pragma unroll 4
                for (int kk = 0; kk < 64; ++kk) { const float wv = Wl[(size_t)(kc * 64 + kk) * NMOD];
#pragma unroll
                    for (int j = 0; j < 17; ++j) acc[j] += cact[(F.wave + 8 * j) * 64 + kk] * wv; }
            }
            if (F.lane < 48) { const float bv = INP(I_BADA)[l * NMOD + ncol];
#pragma unroll
                for (int j = 0; j < 17; ++j) F.mod[((size_t)l * NSEQ + F.wave + 8 * j) * NMOD + ncol] = acc[j] + bv; }
        }
        __syncthreads();
    }
    lf32* scr = (lf32*)(F.lds + F.wave * 16384);
    const int gw = F.bid * NWAVES + F.wave, NGW = F.G * NWAVES;
    constexpr int IT_IN = 121 * 16, IT_OUT = 32 * 16, IT_FI = 176 * 16, IT_FO = 32 * 44, IT_L = IT_IN + IT_OUT + IT_FI + IT_FO;
    for (int it = gw; it < DEPTH * IT_L; it += NGW) {
        const int l = it / IT_L; int r = it - l * IT_L;
        if (r < IT_IN) { const int nb = r >> 4, kb = r & 15;
            const int src = nb < 76 ? nb * 32 : nb < 88 ? 2444 + (nb - 76) * 32 : nb < 120 ? 2828 + (nb - 88) * 32 : 2432;
            transpose_item(INP(I_WIN) + (size_t)l * D * 3852, 3852, D, kb * 64, src, nb == 120 ? 12 : 32, F.win_t + (size_t)l * NIN * D, nb * 32, scr, F.lane); continue; }
        r -= IT_IN;
        if (r < IT_OUT) { const int nb = r >> 4, kb = r & 15;
            transpose_item(INP(I_WOUT) + (size_t)l * D * D, D, D, kb * 64, nb * 32, 32, F.wout_t + (size_t)l * D * D, nb * 32, scr, F.lane); continue; }
        r -= IT_OUT;
        if (r < IT_FI) { const int nb = r >> 4, kb = r & 15; const int pn = nb >> 3, bj = (nb >> 2) & 1, ib = nb & 3;
            transpose_item(INP(I_WFI) + (size_t)l * D * NFI, NFI, D, kb * 64, bj * FF + 128 * pn + 32 * ib, 32, F.wfi_t + (size_t)l * NFI * D, nb * 32, scr, F.lane); continue; }
        r -= IT_FI;
        { const int nb = r / 44, kb = r - nb * 44;
            transpose_item(INP(I_WFO) + (size_t)l * FF * D, D, FF, kb * 64, nb * 32, 32, F.wfo_t + (size_t)l * D * FF, nb * 32, scr, F.lane); }
    }
}

__device__ __forceinline__ void norm_phase(const Args& A, Frame& F, int l, int which) {
    const int gw = F.bid * NWAVES + F.wave, NGW = F.G * NWAVES;
    float* xres = F.out;
    const int nrows = which == 0 ? MEXT : M;
    for (int row = gw; row < nrows; row += NGW) {
        if (row >= M) {
            const GAS f32x4* sr = (const GAS f32x4*)(INP(I_SSHIFT) + ((size_t)l * 128 + (row - M)) * D) + F.lane;
            GAS unsigned long long* o8 = (GAS unsigned long long*)(F.hb + (size_t)row * D) + F.lane;
#pragma unroll
            for (int j = 0; j < 4; ++j) { const f32x4 v = sr[64 * j]; o8[64 * j] = (unsigned long long)pk2(v.x, v.y) | ((unsigned long long)pk2(v.z, v.w) << 32); }
            continue;
        }
        const float* xrow = (which == 0 && l == 0) ? (row < MPR ? INP(I_XP) + (size_t)row * D : INP(I_XS) + (size_t)(row - MPR) * D) : xres + (size_t)row * D;
        const GAS f32x4* xr = (const GAS f32x4*)xrow + F.lane;
        f32x4 v[4]; float ss = 0.f;
#pragma unroll
        for (int j = 0; j < 4; ++j) { v[j] = xr[64 * j]; ss += (v[j].x * v[j].x + v[j].y * v[j].y) + (v[j].z * v[j].z + v[j].w * v[j].w); }
        const float rstd = 1.f / sqrtf(wave_sum(ss) * (1.f / D) + 1e-6f);
        if (which == 2) {
            const GAS f32x4* wr = (const GAS f32x4*)INP(I_FNW) + F.lane;
            GAS f32x4* o = (GAS f32x4*)(xres + (size_t)row * D) + F.lane;
#pragma unroll
            for (int j = 0; j < 4; ++j) o[64 * j] = v[j] * rstd * wr[64 * j];
            continue;
        }
        const int seq = seq_of_row(row);
        const float* mrow = F.mod + ((size_t)l * NSEQ + seq) * NMOD + (which ? 3072 : 0);
        const GAS f32x4* shp = (const GAS f32x4*)mrow + F.lane;
        const GAS f32x4* scp = (const GAS f32x4*)(mrow + 1024) + F.lane;
        const GAS f32x4* wr = (const GAS f32x4*)((which ? INP(I_NFW) : INP(I_NMW)) + (size_t)l * D) + F.lane;
        const bool last = which == 0 && (row < MPR ? (row & 2047) == 2047 : ((row - MPR) & 3) == 3);
        float* so = nullptr;
        if (last) so = F.out + (row < MPR ? O_PSHIFT + ((size_t)l * 8 + (row >> 11)) * D : O_SSHIFT + ((size_t)l * 128 + ((row - MPR) >> 2)) * D);
        GAS unsigned long long* o8 = (GAS unsigned long long*)(F.hb + (size_t)row * D) + F.lane;
#pragma unroll
        for (int j = 0; j < 4; ++j) {
            const f32x4 hv = (v[j] * rstd * wr[64 * j]) * (scp[64 * j] + 1.f) + shp[64 * j];
            o8[64 * j] = (unsigned long long)pk2(hv.x, hv.y) | ((unsigned long long)pk2(hv.z, hv.w) << 32);
            if (last) ((GAS f32x4*)so + F.lane)[64 * j] = hv;
        }
    }
}

constexpr int TC = 32;
__device__ __forceinline__ void ld8(const lf32* p, float (&v)[8]) { const f32x4 a = *(const LAS f32x4*)p, b = *(const LAS f32x4*)(p + 4); v[0] = a.x; v[1] = a.y; v[2] = a.z; v[3] = a.w; v[4] = b.x; v[5] = b.y; v[6] = b.z; v[7] = b.w; }

__device__ __forceinline__ void rwkv_job(const Args& A, Frame& F, int l, int s, int h) {
    lf32* L = (lf32*)F.lds;
    lf32 *XL = L, *SA = L + 4096, *SD = L + 6144, *SB = L + 8192, *SK = L + 10240, *SDR = L + 12288, *SV = L + 14336, *SG = L + 16384, *SO = L + 18432, *SC = L + 20480,
         *W2 = L + 20608, *A2 = L + 22656, *G2 = L + 24704, *PRM = L + 28800, *MU = L + 29248;
    const int T = s < 8 ? 2048 : 4; const int row0 = s < 8 ? s * 2048 : MPR + (s - 8) * 4;
    const int tid = F.tid, lane = F.lane, wave = F.wave;
    __syncthreads();
    for (int i = tid; i < 2048; i += 512) { const int r = i >> 6, j = i & 63;
        W2[i] = INP(I_W2)[((size_t)l * 32 + r) * 384 + h * 64 + j]; A2[i] = INP(I_A2)[((size_t)l * 32 + r) * 384 + h * 64 + j]; }
    for (int i = tid; i < 4096; i += 512) { const int r = i >> 6, j = i & 63; G2[i] = INP(I_G2)[((size_t)l * 64 + r) * 384 + h * 64 + j]; }
    if (tid < 64) { const int c = l * 384 + h * 64 + tid;
        PRM[tid] = INP(I_W0)[c]; PRM[64 + tid] = INP(I_A0)[c]; PRM[128 + tid] = INP(I_KK)[c]; PRM[192 + tid] = INP(I_KA)[c]; PRM[256 + tid] = INP(I_RK)[c]; PRM[320 + tid] = INP(I_LNW)[c]; PRM[384 + tid] = INP(I_LNB)[c]; }
    if (tid < 320) { const int c = tid < 192 ? (tid >> 6) * 384 + h * 64 + (tid & 63) : 1152 + (tid - 192); MU[tid] = INP(I_MU)[l * 1280 + c]; }
    const int col = tid >> 3, ks = tid & 7;
    float st[8];
    float* sout = F.out + (s < 8 ? O_PRWKV + (((size_t)l * 8 + s) * 6 + h) * 4096 : O_SRWKV + (((size_t)l * 128 + (s - 8)) * 6 + h) * 4096) + col * 64 + ks * 8;
    if (s < 8) {
#pragma unroll
        for (int j = 0; j < 8; ++j) st[j] = 0.f;
    } else { const float* sp = INP(I_SRWKV) + (((size_t)l * 128 + (s - 8)) * 6 + h) * 4096 + col * 64 + ks * 8;
        const f32x4 a = *(const f32x4*)sp, b = *(const f32x4*)(sp + 4); st[0] = a.x; st[1] = a.y; st[2] = a.z; st[3] = a.w; st[4] = b.x; st[5] = b.y; st[6] = b.z; st[7] = b.w; }
    const bf16* P = F.p;
    const size_t prevrow = (size_t)(M + (s - 8)) * NIN;
    for (int c0 = 0; c0 < T; c0 += TC) {
        const int n = (T - c0) < TC ? (T - c0) : TC;
        __syncthreads();
        for (int idx = tid; idx < n * 128; idx += 512) { const int t = idx >> 7, i = idx & 127; const int tt = c0 + t;
            const float cur = bf2f(P[(size_t)(row0 + tt) * NIN + 1152 + i]);
            const float prv = tt > 0 ? bf2f(P[(size_t)(row0 + tt - 1) * NIN + 1152 + i]) : (s < 8 ? 0.f : bf2f(P[prevrow + 1152 + i]));
            const float xs = cur + MU[192 + i] * (prv - cur);
            XL[idx] = i < 32 ? tanhf(xs) : i < 64 ? xs : sigmoidf_(xs); }
        __syncthreads();
        for (int t = wave; t < n; t += 8) { const int tt = c0 + t; const size_t rb = (size_t)(row0 + tt) * NIN + h * 64 + lane;
            float cr = bf2f(P[rb]), ck = bf2f(P[rb + 384]), cv = bf2f(P[rb + 768]); float pr, pk, pv;
            if (tt > 0) { pr = bf2f(P[rb - NIN]); pk = bf2f(P[rb - NIN + 384]); pv = bf2f(P[rb - NIN + 768]); }
            else if (s >= 8) { const size_t pb = prevrow + h * 64 + lane; pr = bf2f(P[pb]); pk = bf2f(P[pb + 384]); pv = bf2f(P[pb + 768]); }
            else { pr = 0.f; pk = 0.f; pv = 0.f; }
            const float r = cr + MU[lane] * (pr - cr), k = ck + MU[64 + lane] * (pk - ck), v = cv + MU[128 + lane] * (pv - cv);
            float wp = PRM[lane], ap = PRM[64 + lane], g = 0.f;
            const lf32* xl = XL + t * 128;
#pragma unroll 8
            for (int i = 0; i < 32; ++i) { wp += xl[i] * W2[i * 64 + lane]; ap += xl[32 + i] * A2[i * 64 + lane]; }
#pragma unroll 8
            for (int i = 0; i < 64; ++i) g += xl[64 + i] * G2[i * 64 + lane];
            const float w = -softplusf_(-wp) - 0.5f; const float d = __expf(-__expf(w)); const float alr = sigmoidf_(ap);
            const float kkr = k * PRM[128 + lane]; const float kk = kkr * (1.f / sqrtf(wave_sum(kkr * kkr) + 1e-6f));
            const float kp = k * (1.f + (alr - 1.f) * PRM[192 + lane]);
            const float b = kk * alr;
            const float br = wave_sum(b * r), kr = wave_sum(kp * r), bc = wave_sum(r * kp * PRM[256 + lane]);
            const int o = t * 64 + lane;
            SA[o] = -kk; SD[o] = d; SB[o] = b; SK[o] = kp; SDR[o] = d * r; SV[o] = v; SG[o] = g;
            if (lane == 0) { SC[t * 4] = br; SC[t * 4 + 1] = kr; SC[t * 4 + 2] = bc; }
        }
        __syncthreads();
        for (int t = 0; t < n; ++t) {
            float a8[8], q8[8]; ld8(SA + t * 64 + ks * 8, a8); ld8(SDR + t * 64 + ks * 8, q8);
            float p1 = 0.f, p2 = 0.f;
#pragma unroll
            for (int j = 0; j < 8; ++j) { p1 += st[j] * a8[j]; p2 += st[j] * q8[j]; }
            p1 = red8(p1); p2 = red8(p2);
            float d8[8], b8[8], k8[8]; ld8(SD + t * 64 + ks * 8, d8); ld8(SB + t * 64 + ks * 8, b8); ld8(SK + t * 64 + ks * 8, k8);
            const float vv = SV[t * 64 + col]; const float br = SC[t * 4], kr = SC[t * 4 + 1];
#pragma unroll
            for (int j = 0; j < 8; ++j) st[j] = st[j] * d8[j] + (p1 * b8[j] + vv * k8[j]);
            if (ks == 0) SO[t * 64 + col] = p2 + p1 * br + vv * kr;
        }
        __syncthreads();
        for (int t = wave; t < n; t += 8) { const int o = t * 64 + lane;
            const float y = SO[o]; const float mu = wave_sum(y) * (1.f / 64.f); const float dv = y - mu; const float var = wave_sum(dv * dv) * (1.f / 64.f);
            const float yn = dv * (1.f / sqrtf(var + 64e-5f)) * PRM[320 + lane] + PRM[384 + lane];
            const float res = (yn + SC[t * 4 + 2] * SV[o]) * SG[o];
            F.hb[(size_t)(row0 + c0 + t) * D + h * 64 + lane] = (bf16)f2bf(res); }
    }
    { f32x4 a = {st[0], st[1], st[2], st[3]}, b = {st[4], st[5], st[6], st[7]}; *(f32x4*)sout = a; *(f32x4*)(sout + 4) = b; }
}

__device__ __forceinline__ void gdn_job(const Args& A, Frame& F, int l, int s, int h) {
    lf32* L = (lf32*)F.lds;
    lf32 *SKn = L, *SQn = L + 2048, *SV = L + 4096, *SZ = L + 6144, *SO = L + 8192, *SC = L + 10240, *CW = L + 10368, *NW = L + 11136, *ST = L + 11264;
    const int T = s < 8 ? 2048 : 4; const int row0 = s < 8 ? s * 2048 : MPR + (s - 8) * 4;
    const int tid = F.tid, lane = F.lane, wave = F.wave;
    __syncthreads();
    for (int i = tid; i < 768; i += 512) { const int jj = i / 192, r = i - jj * 192; const int ch = r >> 6, j = r & 63; CW[i] = INP(I_CONVW)[((size_t)l * 4 + jj) * 1152 + ch * 384 + h * 64 + j]; }
    if (tid < 64) NW[tid] = INP(I_GNW)[l * 64 + tid];
    const float Aneg = -__expf(INP(I_ALOG)[l * 6 + h]); const float dtb = INP(I_DTB)[l * 6 + h];
    const int col = tid >> 3, ks = tid & 7;
    float st[8];
    float* sout = F.out + (s < 8 ? O_PGDN + (((size_t)l * 8 + s) * 6 + h) * 4096 : O_SGDN + (((size_t)l * 128 + (s - 8)) * 6 + h) * 4096);
    if (s < 8) {
#pragma unroll
        for (int j = 0; j < 8; ++j) st[j] = 0.f;
    } else { const float* sp = INP(I_SGDN) + (((size_t)l * 128 + (s - 8)) * 6 + h) * 4096;
        for (int i = tid; i < 4096; i += 512) ST[(i >> 6) * 65 + (i & 63)] = sp[i];
        __syncthreads();
#pragma unroll
        for (int j = 0; j < 8; ++j) st[j] = ST[(ks * 8 + j) * 65 + col]; }
    const bf16* P = F.p;
    const float* cbuf = INP(I_SCONV) + ((size_t)l * 128 + (s - 8)) * 3 * 1152;
    for (int c0 = 0; c0 < T; c0 += TC) {
        const int n = (T - c0) < TC ? (T - c0) : TC;
        __syncthreads();
        for (int t = wave; t < n; t += 8) { const int tt = c0 + t; const size_t rb = (size_t)(row0 + tt) * NIN;
            float val[3];
#pragma unroll
            for (int ch = 0; ch < 3; ++ch) { float acc = 0.f;
#pragma unroll
                for (int jj = 0; jj < 4; ++jj) { const int tau = tt - 3 + jj;
                    float x;
                    if (tau >= 0) x = bf2f(P[(size_t)(row0 + tau) * NIN + P_GQKV + ch * 384 + h * 64 + lane]);
                    else x = s < 8 ? 0.f : cbuf[(3 + tau) * 1152 + ch * 384 + h * 64 + lane];
                    acc += CW[(jj * 3 + ch) * 64 + lane] * x; }
                val[ch] = siluf_(acc); }
            const float qn = val[0] * (1.f / sqrtf(wave_sum(val[0] * val[0]) + 1e-6f)) * 0.125f;
            const float kn = val[1] * (1.f / sqrtf(wave_sum(val[1] * val[1]) + 1e-6f));
            const float kq = wave_sum(kn * qn);
            const int o = t * 64 + lane;
            SKn[o] = kn; SQn[o] = qn; SV[o] = val[2]; SZ[o] = bf2f(P[rb + P_GZ + h * 64 + lane]);
            if (lane == 0) { const float beta = sigmoidf_(bf2f(P[rb + P_BETA + h])); const float g = Aneg * softplusf_(bf2f(P[rb + P_APRE + h]) + dtb);
                SC[t * 4] = __expf(g); SC[t * 4 + 1] = beta; SC[t * 4 + 2] = kq; }
        }
        __syncthreads();
        for (int t = 0; t < n; ++t) {
            float k8[8], q8[8]; ld8(SKn + t * 64 + ks * 8, k8); ld8(SQn + t * 64 + ks * 8, q8);
            float p1 = 0.f, p2 = 0.f;
#pragma unroll
            for (int j = 0; j < 8; ++j) { p1 += st[j] * k8[j]; p2 += st[j] * q8[j]; }
            p1 = red8(p1); p2 = red8(p2);
            const float eg = SC[t * 4], beta = SC[t * 4 + 1], kq = SC[t * 4 + 2];
            const float vnew = beta * (SV[t * 64 + col] - eg * p1);
#pragma unroll
            for (int j = 0; j < 8; ++j) st[j] = st[j] * eg + k8[j] * vnew;
            if (ks == 0) SO[t * 64 + col] = eg * p2 + vnew * kq;
        }
        __syncthreads();
        for (int t = wave; t < n; t += 8) { const int o = t * 64 + lane;
            const float y = SO[o]; const float ms = wave_sum(y * y) * (1.f / 64.f);
            const float res = y * (1.f / sqrtf(ms + 1e-6f)) * NW[lane] * siluf_(SZ[o]);
            F.hb[(size_t)(row0 + c0 + t) * D + 384 + h * 64 + lane] = (bf16)f2bf(res); }
    }
    __syncthreads();
#pragma unroll
    for (int j = 0; j < 8; ++j) ST[(ks * 8 + j) * 65 + col] = st[j];
    __syncthreads();
    for (int i = tid; i < 4096; i += 512) sout[i] = ST[(i >> 6) * 65 + (i & 63)];
    if (tid < 192) { const int ch = tid >> 6, j = tid & 63;
        float* co = F.out + (s < 8 ? O_PCONV + ((size_t)l * 8 + s) * 3 * 1152 : O_SCONV + ((size_t)l * 128 + (s - 8)) * 3 * 1152) + ch * 384 + h * 64 + j;
#pragma unroll
        for (int i = 0; i < 3; ++i) { const int tau = T - 3 + i;
            co[i * 1152] = tau >= 0 ? bf2f(P[(size_t)(row0 + tau) * NIN + P_GQKV + ch * 384 + h * 64 + j]) : (s < 8 ? 0.f : cbuf[(3 + tau) * 1152 + ch * 384 + h * 64 + j]); } }
}

__device__ __forceinline__ void hgrn_job(const Args& A, Frame& F, int l, int s, int h) {
    lf32* L = (lf32*)F.lds;
    lf32 *SF = L, *SKK = L + 2048, *SQ = L + 4096, *SI = L + 6144, *SZ = L + 8192, *SO = L + 10240, *NW = L + 12288, *ST = L + 12416;
    const int T = s < 8 ? 2048 : 4; const int row0 = s < 8 ? s * 2048 : MPR + (s - 8) * 4;
    const int tid = F.tid, lane = F.lane, wave = F.wave;
    __syncthreads();
    if (tid < 64) NW[tid] = INP(I_HNW)[l * 64 + tid];
    float lb = 0.f;
    if (l == 1) { const float l0 = INP(I_LBL)[h * 64 + lane], l1 = INP(I_LBL)[256 + h * 64 + lane]; lb = 1.f / (1.f + __expf(l0 - l1)); }
    const int col = tid >> 3, ks = tid & 7;
    float st[8];
    float* sout = F.out + (s < 8 ? O_PHGRN + (((size_t)l * 8 + s) * 4 + h) * 4096 : O_SHGRN + (((size_t)l * 128 + (s - 8)) * 4 + h) * 4096);
    if (s < 8) {
#pragma unroll
        for (int j = 0; j < 8; ++j) st[j] = 0.f;
    } else { const float* sp = INP(I_SHGRN) + (((size_t)l * 128 + (s - 8)) * 4 + h) * 4096;
        for (int i = tid; i < 4096; i += 512) ST[(i >> 6) * 65 + (i & 63)] = sp[i];
        __syncthreads();
#pragma unroll
        for (int j = 0; j < 8; ++j) st[j] = ST[(ks * 8 + j) * 65 + col]; }
    const bf16* P = F.p;
    for (int c0 = 0; c0 < T; c0 += TC) {
        const int n = (T - c0) < TC ? (T - c0) : TC;
        __syncthreads();
        for (int t = wave; t < n; t += 8) { const size_t rb = (size_t)(row0 + c0 + t) * NIN + P_H + h * 64 + lane;
            const float q = bf2f(P[rb]), f = bf2f(P[rb + 256]), iv = bf2f(P[rb + 512]), z = bf2f(P[rb + 768]);
            const float sg = sigmoidf_(f), sgn = 1.f / (1.f + __expf(f));
            const int o = t * 64 + lane;
            SF[o] = lb + (1.f - lb) * sg; SKK[o] = (1.f - lb) * sgn; SQ[o] = siluf_(q); SI[o] = iv; SZ[o] = z; }
        __syncthreads();
        for (int t = 0; t < n; ++t) {
            float f8[8], k8[8], q8[8]; ld8(SF + t * 64 + ks * 8, f8); ld8(SKK + t * 64 + ks * 8, k8); ld8(SQ + t * 64 + ks * 8, q8);
            const float iv = SI[t * 64 + col];
            float p = 0.f;
#pragma unroll
            for (int j = 0; j < 8; ++j) { st[j] = st[j] * f8[j] + k8[j] * iv; p += q8[j] * st[j]; }
            p = red8(p);
            if (ks == 0) SO[t * 64 + col] = p;
        }
        __syncthreads();
        for (int t = wave; t < n; t += 8) { const int o = t * 64 + lane;
            const float y = SO[o]; const float ms = wave_sum(y * y) * (1.f / 64.f);
            const float res = y * (1.f / sqrtf(ms + 1e-6f)) * NW[lane] * sigmoidf_(SZ[o]);
            F.hb[(size_t)(row0 + c0 + t) * D + 768 + h * 64 + lane] = (bf16)f2bf(res); }
    }
    __syncthreads();
#pragma unroll
    for (int j = 0; j < 8; ++j) ST[(ks * 8 + j) * 65 + col] = st[j];
    __syncthreads();
    for (int i = tid; i < 4096; i += 512) sout[i] = ST[(i >> 6) * 65 + (i & 63)];
}

__device__ __forceinline__ void run_job(const Args& A, Frame& F, int l, int s, int hh) {
    if (hh < 6) rwkv_job(A, F, l, s, hh); else if (hh < 12) gdn_job(A, F, l, s, hh - 6); else hgrn_job(A, F, l, s, hh - 12);
}
__device__ __forceinline__ void scan_phase(const Args& A, Frame& F, int l) {
    const bool two = F.G > 128; const int nshort_wg = two ? F.G - 128 : F.G; const int me = two ? F.bid - 128 : F.bid;
    for (int it = 0;; ++it) {
        int s, hh;
        const int jl = F.bid + it * F.G;
        if (jl < 128) { s = jl & 7; hh = jl >> 3; }
        else { const int its = two ? it : it - (128 - F.bid + F.G - 1) / F.G; const int q = me + its * nshort_wg; if (me < 0 || its < 0 || q >= 2048) break; s = 8 + (q & 127); hh = q >> 7; }
        run_job(A, F, l, s, hh);
    }
}

__global__ void __launch_bounds__(NWAVES * 64, 2) mk_fwd(Args args) {
    const Args& A = args;
    extern __shared__ __attribute__((aligned(16))) unsigned char lds[];
    Frame F;
    F.lds = (LAS unsigned char*)lds;
    F.MISC = (volatile LAS unsigned*)(F.lds + MISC_OFF);
    F.tid = threadIdx.x; F.lane = F.tid & 63; F.wave = __builtin_amdgcn_readfirstlane(F.tid >> 6);
    F.G = gridDim.x; F.bid = blockIdx.x;
    unsigned char* ws = args.ws;
    F.ctl = (gu32*)(ws + WS_CTL);
    F.out = args.out;
    F.mod = (float*)(ws + WS_MOD); F.win_t = (bf16*)(ws + WS_WIN); F.wout_t = (bf16*)(ws + WS_WOUT); F.wfi_t = (bf16*)(ws + WS_WFI); F.wfo_t = (bf16*)(ws + WS_WFO);
    F.hb = (bf16*)(ws + WS_HB); F.p = (bf16*)(ws + WS_P);
    for (int u = F.tid; u < (LDS_BYTES - LDSCTL_OFF) / 4; u += NWAVES * 64) ((LAS unsigned*)(F.lds + LDSCTL_OFF))[u] = 0u;
    __syncthreads();
    XcdBarrier bar; bar.bar = (unsigned*)(F.ctl + CW_BAR); bar.x = 0; bar.st = nullptr;
    if (MK_N_LAUNCHES == 1) bar = xcd_barrier_post((unsigned*)(F.ctl + CW_BAR), F.MISC + 8);
    const int lo = args.ph_lo, hi = args.ph_hi;
#ifndef PH_MASK
#define PH_MASK 0xFFFF
#endif

    for (int ph = lo; ph < hi; ++ph) {
        { int t_ = threadIdx.x; asm volatile("" : "+v"(t_)); F.tid = t_; F.lane = t_ & 63; F.wave = __builtin_amdgcn_readfirstlane(t_ >> 6);
          int b_ = blockIdx.x; asm volatile("" : "+s"(b_)); F.bid = b_; }
        if (!((PH_MASK >> (ph == 0 ? 0 : ph == 15 ? 8 : 1 + ((ph - 1) % 7))) & 1)) continue;
        if (ph == 0) p0_prologue(A, F);
        else if (ph == 15) norm_phase(A, F, 0, 2);
        else {
            const int l = (ph - 1) / 7, k = (ph - 1) - 7 * l;
            if (k == 0 || k == 4) norm_phase(A, F, l, k == 0 ? 0 : 1);
            else if (k == 2) scan_phase(A, F, l);
            else {
                pg8::Gemm g; pg8::EpiAny E; E.mode = (k == 1) ? 0 : (k == 5) ? 2 : 1;
                const float* x0p = (l == 0 && k == 3) ? INP(I_XP) : F.out; const float* x0s = (l == 0 && k == 3) ? INP(I_XS) : F.out + (size_t)MPR * D;
                E.xin_p = x0p; E.xin_s = x0s; E.xout = F.out; E.gate = F.mod + (size_t)l * NSEQ * NMOD + (k == 3 ? 2048 : 5120);
                E.O = F.p; E.ldc = (k == 1) ? NIN : FF;
                g.A = (k == 6) ? F.p : F.hb;
                g.Bt = (k == 1) ? F.win_t + (size_t)l * NIN * D : (k == 3) ? F.wout_t + (size_t)l * D * D : (k == 5) ? F.wfi_t + (size_t)l * NFI * D : F.wfo_t + (size_t)l * D * FF;
                g.M = (k == 1) ? MPAD : M; g.N = (k == 1) ? NIN : (k == 5) ? NFI : D; g.K = (k == 6) ? FF : D;
                pg8::StaticOrder S; S.init(g.M, g.N, F.G, F.bid);
                pg8::gemm_phase<pg8::EpiAny, pg8::StaticOrder, true, true>(F.lds, g, S, E, F.tid);
            }
        }
        if (ph + 1 < hi) xcd_barrier(bar);
    }
}

extern "C" void kernel_launch(void* const* d_in, const int* in_sizes, int n_in, void* d_out, int out_size, void* d_ws, size_t ws_size, hipStream_t stream) {
    static int grid = 0;
    if (grid == 0) {
        if (n_in != 35 || (size_t)out_size != O_TOTAL || ws_size < WS_END) { fprintf(stderr, "kernel_launch: unexpected shapes (n_in %d out %d ws %zu); nothing launched\n", n_in, out_size, ws_size); grid = -1; return; }
        int dev = 0, cus = 0, per_cu = 0;
        if (hipGetDevice(&dev) != hipSuccess || hipDeviceGetAttribute(&cus, hipDeviceAttributeMultiprocessorCount, dev) != hipSuccess) { grid = -1; return; }
        if (hipFuncSetAttribute((const void*)mk_fwd, hipFuncAttributeMaxDynamicSharedMemorySize, LDS_BYTES) != hipSuccess) { fprintf(stderr, "kernel_launch: hipFuncSetAttribute failed\n"); grid = -1; return; }
        if (hipOccupancyMaxActiveBlocksPerMultiprocessor(&per_cu, (const void*)mk_fwd, NWAVES * 64, LDS_BYTES) != hipSuccess || per_cu < 1) { fprintf(stderr, "kernel_launch: occupancy query says %d\n", per_cu); }
        (void)hipGetLastError();
        grid = cus;
    }
    if (grid < 0) return;
    (void)hipMemsetAsync((char*)d_ws + WS_CTL, 0, CTL_ZERO_BYTES, stream);
    Args a{};
    for (int i = 0; i < 35; ++i) a.in[i] = (const float*)d_in[i];
    a.out = (float*)d_out; a.ws = (unsigned char*)d_ws;
    if (MK_N_LAUNCHES == 1) { a.ph_lo = 0; a.ph_hi = NPHASES; hipLaunchKernelGGL(mk_fwd, dim3(grid), dim3(NWAVES * 64), LDS_BYTES, stream, a); }
    else for (int ph = 0; ph < NPHASES; ++ph) { a.ph_lo = ph; a.ph_hi = ph + 1; hipLaunchKernelGGL(mk_fwd, dim3(grid), dim3(NWAVES * 64), LDS_BYTES, stream, a); }
}
```

```cpp
#include <hip/hip_runtime.h>
#include <cstdio>
#include <cstdint>
namespace pg8 {
#define PG8_LAS __attribute__((address_space(3)))
typedef unsigned short bf16_t;
typedef short bf16x8 __attribute__((ext_vector_type(8)));
typedef float f32x4 __attribute__((ext_vector_type(4)));
typedef unsigned u32x4 __attribute__((ext_vector_type(4)));
constexpr int BM = 256, BK = 64, HALF = 128, HTB = HALF * BK * 2  , STAGE_BYTES = 8 * HTB, NXCD = 8, WGM = 8;

__host__ __device__ __forceinline__ int lds_byte(int r, int c) { const int st = (r >> 4) * 2 + (c >> 5), rr = r & 15, cc = c & 31, ob = rr * 64 + cc * 2; return st * 1024 + (ob ^ (((ob >> 9) & 1) << 5)); }
__host__ __device__ __forceinline__ void stage_rc(int b, int& R, int& C) { const int st = b / 1024, sb = b % 1024, swz = sb ^ (((sb >> 9) & 1) << 5); R = (st >> 1) * 16 + swz / 64; C = (st & 1) * 32 + (swz % 64) / 2; }
__host__ __device__ __forceinline__ int perm32(int rho) { const int n = rho >> 4, i = rho & 15; return 8 * (i >> 2) + 4 * n + (i & 3); }

struct Unit { int pm, pn; };
struct Gemm { const bf16_t* A; const bf16_t* Bt; int M, N, K; };

struct StaticOrder {
    int nM, nN, nwg, G, c;
    __host__ __device__ void init(int M, int N, int G_, int c_) { nM = M / BM; nN = N / BM; nwg = nM * nN; G = G_; c = c_; }
    __host__ __device__ bool next(int i, Unit& u) const {
        const long L = (long)i * G + c; if (L >= nwg) return false;
        int wgid = (int)L; { const int q = nwg / NXCD, r = nwg % NXCD, xcd = wgid % NXCD, off = wgid / NXCD; wgid = (xcd < r ? xcd * (q + 1) : r * (q + 1) + (xcd - r) * q) + off; }
        const int nig = WGM * nN, gid = wgid / nig, fm = gid * WGM, gsz = (nM - fm) < WGM ? (nM - fm) : WGM;
        u.pm = fm + ((wgid % nig) % gsz); u.pn = (wgid % nig) / gsz; return true;
    }
    __device__ __forceinline__ void a_ready(const Unit&) const {}
    __device__ __forceinline__ void done(const Unit&) const {}
};

__device__ __forceinline__ unsigned cvt_pk_bf16(float lo, float hi) { unsigned r; asm volatile("v_cvt_pk_bf16_f32 %0, %1, %2" : "=v"(r) : "v"(lo), "v"(hi)); return r; }
typedef float f32x2 __attribute__((ext_vector_type(2)));

struct EpiBf16 {
    static constexpr bool PERM = true, AFTER_DRAIN = false;
    bf16_t* O; int ldc;
    __device__ __forceinline__ void operator()(const f32x4 (&acc)[2][2][4][2], const Unit& u, int wr, int wc, int fr, int fq) const {
        const int row0 = u.pm * BM + wr * 64 + fr; const int col0 = u.pn * BM + wc * 32 + 8 * fq;
#pragma unroll
        for (int ai = 0; ai < 2; ++ai)
#pragma unroll
            for (int m = 0; m < 4; ++m) { bf16_t* rowp = O + (size_t)(row0 + ai * HALF + m * 16) * ldc + col0;
#pragma unroll
                for (int bj = 0; bj < 2; ++bj) { const f32x4 v0 = acc[ai][bj][m][0], v1 = acc[ai][bj][m][1];
                    u32x4 w; w.x = cvt_pk_bf16(v0[0], v0[1]); w.y = cvt_pk_bf16(v0[2], v0[3]); w.z = cvt_pk_bf16(v1[0], v1[1]); w.w = cvt_pk_bf16(v1[2], v1[3]);
                    *(u32x4*)(rowp + bj * HALF) = w; } }
    }
};

struct EpiResid {
    static constexpr bool PERM = true, AFTER_DRAIN = false;
    const float* xin_p; const float* xin_s; float* xout; const float* gate;
    __device__ __forceinline__ void operator()(const f32x4 (&acc)[2][2][4][2], const Unit& u, int wr, int wc, int fr, int fq) const {
        const int row0 = u.pm * BM + wr * 64 + fr; const int col0 = u.pn * BM + wc * 32 + 8 * fq;
#pragma unroll
        for (int ai = 0; ai < 2; ++ai)
#pragma unroll
            for (int m = 0; m < 4; ++m) {
                const int row = row0 + ai * HALF + m * 16;
                const int seq = row < 16384 ? (row >> 11) : 8 + ((row - 16384) >> 2);
                const float* xi = (row < 16384 ? xin_p + (size_t)row * 1024 : xin_s + (size_t)(row - 16384) * 1024) + col0;
                const float* g = gate + (size_t)seq * 6144 + col0;
                float* xo = xout + (size_t)row * 1024 + col0;
#pragma unroll
                for (int bj = 0; bj < 2; ++bj) {
                    const f32x4 x0 = *(const f32x4*)(xi + bj * HALF), x1 = *(const f32x4*)(xi + bj * HALF + 4);
                    const f32x4 g0 = *(const f32x4*)(g + bj * HALF), g1 = *(const f32x4*)(g + bj * HALF + 4);
                    *(f32x4*)(xo + bj * HALF) = x0 + g0 * acc[ai][bj][m][0];
                    *(f32x4*)(xo + bj * HALF + 4) = x1 + g1 * acc[ai][bj][m][1]; } }
    }
};

struct EpiSwiGLU {
    static constexpr bool PERM = true, AFTER_DRAIN = false;
    bf16_t* O; int ldc;
    __device__ __forceinline__ void operator()(const f32x4 (&acc)[2][2][4][2], const Unit& u, int wr, int wc, int fr, int fq) const {
        const int row0 = u.pm * BM + wr * 64 + fr; const int col0 = u.pn * HALF + wc * 32 + 8 * fq;
#pragma unroll
        for (int ai = 0; ai < 2; ++ai)
#pragma unroll
            for (int m = 0; m < 4; ++m) { bf16_t* rowp = O + (size_t)(row0 + ai * HALF + m * 16) * ldc + col0;
                float r[8];
#pragma unroll
                for (int n = 0; n < 2; ++n)
#pragma unroll
                    for (int e = 0; e < 4; ++e) { const float gt = acc[ai][0][m][n][e], up = acc[ai][1][m][n][e];
                        r[n * 4 + e] = gt * __builtin_amdgcn_rcpf(1.f + __builtin_amdgcn_exp2f(-1.44269504089f * gt)) * up; }
                u32x4 w; w.x = cvt_pk_bf16(r[0], r[1]); w.y = cvt_pk_bf16(r[2], r[3]); w.z = cvt_pk_bf16(r[4], r[5]); w.w = cvt_pk_bf16(r[6], r[7]);
                *(u32x4*)rowp = w; }
    }
};

struct EpiAny {
    static constexpr bool PERM = true, AFTER_DRAIN = false;
    int mode; bf16_t* O; int ldc; const float* xin_p; const float* xin_s; float* xout; const float* gate;
    __device__ __forceinline__ void operator()(const f32x4 (&acc)[2][2][4][2], const Unit& u, int wr, int wc, int fr, int fq) const {
        if (mode == 0) { EpiBf16 e{O, ldc}; e(acc, u, wr, wc, fr, fq); }
        else if (mode == 1) { EpiResid e{xin_p, xin_s, xout, gate}; e(acc, u, wr, wc, fr, fq); }
        else { EpiSwiGLU e{O, ldc}; e(acc, u, wr, wc, fr, fq); }
    }
};

template <class Epi, class Sched, bool ALIGN_EPI = false, bool SP2 = false>
__device__ __forceinline__ void gemm_phase(PG8_LAS unsigned char* lds, const Gemm g, const Sched& S, const Epi& E, const int tid) {
    const int wid = __builtin_amdgcn_readfirstlane(tid >> 6), lane = tid & 63, wr = wid >> 2, wc = wid & 3, fr = lane & 15, fq = lane >> 4;
    const int K = g.K, nt = K / BK;
    unsigned voffA[2], voffB[2];
#pragma unroll
    for (int i = 0; i < 2; ++i) { int R, C; stage_rc(tid * 16 + i * 8192, R, C); const int Rb = Epi::PERM ? ((R & ~31) + perm32(R & 31)) : R;
        voffA[i] = (unsigned)(R * K + C) * 2u; voffB[i] = (unsigned)(Rb * K + C) * 2u; }
    const size_t kstep = (size_t)(BK * 2);
    const size_t hstep = (size_t)HALF * K * 2;
    const size_t tstep = 2 * hstep;
    const unsigned ldsw = (unsigned)wid * 1024u;
    const int aoff = lds_byte(wr * 64 + fr, fq * 8), boff = lds_byte(wc * 32 + fr, fq * 8);
#define PG8_SA(b, h) (((b) * 2 + (h)) * HTB)
#define PG8_SB(b, h) ((4 + (b) * 2 + (h)) * HTB)
#define PG8_STAGE(bufoff, gbase, voff) do { _Pragma("unroll") for (int _i = 0; _i < 2; ++_i) \
        __builtin_amdgcn_global_load_lds((const unsigned*)((const char*)(gbase) + (voff)[_i]), (PG8_LAS unsigned*)(lds + (bufoff) + ldsw + _i * 8192), 16, 0, 0); } while (0)
#define PG8_LDA(dst, b, h) do { _Pragma("unroll") for (int m = 0; m < 4; ++m) _Pragma("unroll") for (int k = 0; k < 2; ++k) dst[m][k] = *(const PG8_LAS bf16x8*)(lds + PG8_SA(b, h) + aoff + m * 2048 + k * 1024); } while (0)
#define PG8_LDB(dst, b, h) do { _Pragma("unroll") for (int n = 0; n < 2; ++n) _Pragma("unroll") for (int k = 0; k < 2; ++k) dst[n][k] = *(const PG8_LAS bf16x8*)(lds + PG8_SB(b, h) + boff + n * 2048 + k * 1024); } while (0)
#define PG8_MMA(ai, bj, At, Bt) do { __builtin_amdgcn_s_setprio(1); _Pragma("unroll") for (int m = 0; m < 4; ++m) _Pragma("unroll") for (int n = 0; n < 2; ++n) _Pragma("unroll") for (int k = 0; k < 2; ++k) \
        acc[ai][bj][m][n] = __builtin_amdgcn_mfma_f32_16x16x32_bf16(Bt[n][k], At[m][k], acc[ai][bj][m][n], 0, 0, 0); __builtin_amdgcn_s_setprio(0); } while (0)
#define PG8_WAIT_V(n) asm volatile("s_waitcnt vmcnt(" #n ")" ::: "memory")
#define PG8_WAIT_L(n) asm volatile("s_waitcnt lgkmcnt(" #n ")" ::: "memory")
#define PG8_BAR __builtin_amdgcn_s_barrier()
#define PG8_SCHED __builtin_amdgcn_sched_barrier(0)
    Unit cur, nxt; int ui = 0;
    if (!S.next(0, cur)) return;
    f32x4 acc[2][2][4][2];
#pragma unroll
    for (int a = 0; a < 2; ++a)
#pragma unroll
        for (int b = 0; b < 2; ++b)
#pragma unroll
            for (int m = 0; m < 4; ++m)
#pragma unroll
                for (int n = 0; n < 2; ++n) acc[a][b][m][n] = (f32x4){0.f, 0.f, 0.f, 0.f};
    bf16x8 At[4][2], B0[2][2], B1[2][2];
    const char* cA = (const char*)g.A + (size_t)cur.pm * tstep; const char* cB = (const char*)g.Bt + (size_t)cur.pn * tstep;
    S.a_ready(cur);
    if constexpr (SP2) {
        PG8_STAGE(PG8_SB(0, 0), cB, voffB); PG8_STAGE(PG8_SB(0, 1), cB + hstep, voffB); PG8_STAGE(PG8_SA(0, 0), cA, voffA); PG8_STAGE(PG8_SA(0, 1), cA + hstep, voffA);
        if (wr == 1) PG8_BAR;
        PG8_WAIT_V(2); PG8_BAR;
        PG8_STAGE(PG8_SB(1, 0), cB + kstep, voffB); PG8_STAGE(PG8_SA(1, 0), cA + kstep, voffA); PG8_STAGE(PG8_SB(1, 1), cB + hstep + kstep, voffB);
        PG8_WAIT_V(6); PG8_BAR;
    } else {
        PG8_STAGE(PG8_SB(0, 0), cB, voffB); PG8_STAGE(PG8_SA(0, 0), cA, voffA); PG8_STAGE(PG8_SB(0, 1), cB + hstep, voffB); PG8_STAGE(PG8_SA(0, 1), cA + hstep, voffA);
        if (wr == 1) PG8_BAR;
        PG8_WAIT_V(4); PG8_BAR;
        PG8_STAGE(PG8_SB(1, 0), cB + kstep, voffB); PG8_STAGE(PG8_SA(1, 0), cA + kstep, voffA); PG8_STAGE(PG8_SB(1, 1), cB + hstep + kstep, voffB);
        PG8_WAIT_V(6); PG8_BAR;
    }
    for (;;) {
        const bool has_next = S.next(ui + 1, nxt);
        const char* nA = has_next ? (const char*)g.A + (size_t)nxt.pm * tstep : cA; const char* nB = has_next ? (const char*)g.Bt + (size_t)nxt.pn * tstep : cB;
        for (int t = 0; t < nt; t += 2) {
            const bool last = (t == nt - 2);
            const char* a1 = cA + (size_t)(t + 1) * kstep;
            const char* a2 = last ? nA : cA + (size_t)(t + 2) * kstep; const char* b2 = last ? nB : cB + (size_t)(t + 2) * kstep;
            const char* a3 = a2 + kstep; const char* b3 = b2 + kstep;
            if (last && has_next) S.a_ready(nxt);
            if constexpr (SP2) {
            PG8_LDB(B0, 0, 0); PG8_LDB(B1, 0, 1); PG8_SCHED; PG8_LDA(At, 0, 0); PG8_STAGE(PG8_SA(1, 1), a1 + hstep, voffA);
            PG8_WAIT_V(8); PG8_WAIT_L(0); PG8_BAR; PG8_MMA(0, 0, At, B0); PG8_MMA(0, 1, At, B1); PG8_BAR; PG8_SCHED;
            PG8_LDA(At, 0, 1); PG8_STAGE(PG8_SB(0, 0), b2, voffB); PG8_STAGE(PG8_SB(0, 1), b2 + hstep, voffB); PG8_STAGE(PG8_SA(0, 0), a2, voffA);
            PG8_WAIT_V(8); PG8_WAIT_L(0); PG8_BAR; PG8_MMA(1, 0, At, B0); PG8_MMA(1, 1, At, B1); PG8_BAR; PG8_SCHED;
            PG8_LDB(B0, 1, 0); PG8_LDB(B1, 1, 1); PG8_SCHED; PG8_LDA(At, 1, 0); PG8_STAGE(PG8_SA(0, 1), a2 + hstep, voffA);
            PG8_WAIT_V(8); PG8_WAIT_L(0); PG8_BAR; PG8_MMA(0, 0, At, B0); PG8_MMA(0, 1, At, B1); PG8_BAR; PG8_SCHED;
            PG8_LDA(At, 1, 1); PG8_STAGE(PG8_SB(1, 0), b3, voffB); PG8_STAGE(PG8_SB(1, 1), b3 + hstep, voffB); PG8_STAGE(PG8_SA(1, 0), a3, voffA);
            PG8_WAIT_V(8); PG8_WAIT_L(0); PG8_BAR; PG8_MMA(1, 0, At, B0); PG8_MMA(1, 1, At, B1); PG8_BAR; PG8_SCHED;
            } else {
            PG8_LDB(B0, 0, 0); PG8_SCHED; PG8_LDA(At, 0, 0); PG8_STAGE(PG8_SA(1, 1), a1 + hstep, voffA);
            PG8_WAIT_L(8); PG8_BAR; PG8_WAIT_L(0); PG8_MMA(0, 0, At, B0); PG8_BAR; PG8_SCHED;
            PG8_LDB(B1, 0, 1); PG8_STAGE(PG8_SB(0, 0), b2, voffB);
            PG8_BAR; PG8_WAIT_L(0); PG8_MMA(0, 1, At, B1); PG8_BAR;
            PG8_LDA(At, 0, 1); PG8_STAGE(PG8_SA(0, 0), a2, voffA);
            PG8_BAR; PG8_WAIT_L(0); PG8_MMA(1, 0, At, B0); PG8_BAR; PG8_SCHED;
            PG8_STAGE(PG8_SB(0, 1), b2 + hstep, voffB);
            PG8_WAIT_V(6); PG8_BAR; PG8_MMA(1, 1, At, B1); PG8_BAR;
            PG8_LDB(B0, 1, 0); PG8_SCHED; PG8_LDA(At, 1, 0); PG8_STAGE(PG8_SA(0, 1), a2 + hstep, voffA);
            PG8_WAIT_L(8); PG8_BAR; PG8_WAIT_L(0); PG8_MMA(0, 0, At, B0); PG8_BAR; PG8_SCHED;
            PG8_LDB(B1, 1, 1); PG8_STAGE(PG8_SB(1, 0), b3, voffB);
            PG8_BAR; PG8_WAIT_L(0); PG8_MMA(0, 1, At, B1); PG8_BAR;
            PG8_LDA(At, 1, 1); PG8_STAGE(PG8_SA(1, 0), a3, voffA);
            PG8_BAR; PG8_WAIT_L(0); PG8_MMA(1, 0, At, B0); PG8_BAR; PG8_SCHED;
            PG8_STAGE(PG8_SB(1, 1), b3 + hstep, voffB);
            PG8_WAIT_V(6); PG8_BAR; PG8_MMA(1, 1, At, B1); PG8_BAR;
            }
        }
        if constexpr (ALIGN_EPI) { if (wr == 0) PG8_BAR; }
        if constexpr (!Epi::AFTER_DRAIN) { E(acc, cur, wr, wc, fr, fq); S.done(cur); }
        if (!has_next) break;
#pragma unroll
        for (int a = 0; a < 2; ++a)
#pragma unroll
            for (int b = 0; b < 2; ++b)
#pragma unroll
                for (int m = 0; m < 4; ++m)
#pragma unroll
                    for (int n = 0; n < 2; ++n) acc[a][b][m][n] = (f32x4){0.f, 0.f, 0.f, 0.f};
        cur = nxt; cA = nA; cB = nB; ++ui;
        if constexpr (ALIGN_EPI) { if (wr == 1) PG8_BAR; }
    }
    PG8_WAIT_V(0);
    if constexpr (!ALIGN_EPI) { if (wr == 0) PG8_BAR; }
    PG8_BAR;
    if constexpr (Epi::AFTER_DRAIN) { E.fused(acc, cur, wr, wc, fr, fq, lds, wid, lane); S.done(cur); }
#undef PG8_SA
#undef PG8_SB
#undef PG8_STAGE
#undef PG8_LDA
#undef PG8_LDB
#undef PG8_MMA
#undef PG8_WAIT_V
#undef PG8_WAIT_L
#undef PG8_BAR
#undef PG8_SCHED
}
}

#define GAS __attribute__((address_space(1)))
#define LAS __attribute__((address_space(3)))
typedef unsigned short bf16;
typedef unsigned v4u __attribute__((ext_vector_type(4)));
typedef float f32x4 __attribute__((ext_vector_type(4)));
typedef short bf16x8 __attribute__((ext_vector_type(8)));
typedef GAS unsigned gu32;
typedef GAS unsigned long long gu64;
#define RLX_AGENT __ATOMIC_RELAXED, __HIP_MEMORY_SCOPE_AGENT
#define LDS_WAIT() asm volatile("s_waitcnt lgkmcnt(0)" ::: "memory")
#define VM_WAIT() asm volatile("s_waitcnt vmcnt(0)" ::: "memory")
__device__ __forceinline__ unsigned long long rt() { return __builtin_amdgcn_s_memrealtime(); }
__device__ __forceinline__ unsigned f2bf(float f) { unsigned u = __builtin_bit_cast(unsigned, f); return (u + 0x7fffu + ((u >> 16) & 1u)) >> 16; }
__device__ __forceinline__ unsigned pk2(float lo, float hi) { return f2bf(lo) | (f2bf(hi) << 16); }

#define XB_TMO      128
#define XB_XCNT(j)  (256  + 64 * (j))
#define XB_XSUB(j)  (1280 + 64 * (j))
#define XB_XGEN(j)  (2304 + 64 * (j))
#define XB_TOP      3328
#define XB_TOPGEN   3392
#define XCD_BAR_WORDS 3456
#define XB_SPIN_CAP (1u << 18)

__device__ __forceinline__ unsigned xb_ld(unsigned* p)              { return __hip_atomic_load(p, __ATOMIC_RELAXED, __HIP_MEMORY_SCOPE_AGENT); }
__device__ __forceinline__ unsigned xb_add(unsigned* p, unsigned v) { return __hip_atomic_fetch_add(p, v, __ATOMIC_RELAXED, __HIP_MEMORY_SCOPE_AGENT); }
__device__ __forceinline__ unsigned xb_xcc_id() { return (unsigned)__builtin_amdgcn_s_getreg((3 << 11) | 20) & 0xFu; }
#define XB_SPIN(cond, bar) do { unsigned _sp = 0; while (cond) { __builtin_amdgcn_s_sleep(1); \
    if ((++_sp & 255u) == 0u) { if (xb_ld(&(bar)[XB_TMO])) break; if (_sp > XB_SPIN_CAP) { atomicAdd(&(bar)[XB_TMO], 1u); break; } } } } while (0)

struct XcdBarrier {
    unsigned* bar; unsigned x;
    volatile LAS unsigned* st;
};

__device__ __forceinline__ XcdBarrier xcd_barrier_post(unsigned* bar, volatile LAS unsigned* st) {
    XcdBarrier b; b.bar = bar; b.x = xb_xcc_id(); b.st = st;
    if (threadIdx.x == 0) (void)xb_add(&bar[XB_XCNT(b.x)], 1u);
    return b;
}
__device__ __forceinline__ void xcd_barrier_complete(unsigned* bar, unsigned x, unsigned& nloc, unsigned& nx) {
    const unsigned G = gridDim.x * gridDim.y * gridDim.z;
    unsigned sum, cnt, mine, sp = 0u;
    for (;;) {
        sum = 0u; cnt = 0u; mine = 0u;
#pragma unroll
        for (unsigned j = 0; j < 16; ++j) { const unsigned c = xb_ld(&bar[XB_XCNT(j)]); sum += c; cnt += (c > 0u) ? 1u : 0u; mine = (j == x) ? c : mine; }
        if (sum == G) break;
        __builtin_amdgcn_s_sleep(1);
        if ((++sp & 255u) == 0u) { if (xb_ld(&bar[XB_TMO])) break; if (sp > XB_SPIN_CAP) { atomicAdd(&bar[XB_TMO], 1u); break; } }
    }
    nloc = mine > 0u ? mine : 1u; nx = cnt > 0u ? cnt : 1u;
}

__device__ __forceinline__ void xcd_barrier(const XcdBarrier& b) {
    asm volatile("s_waitcnt vmcnt(0)" ::: "memory");
    __syncthreads();
    if (threadIdx.x == 0) {
        unsigned* bar = b.bar;
        __builtin_amdgcn_s_waitcnt(0);
        unsigned nloc = b.st[0], nx = b.st[1];
        if (nloc == 0u) { xcd_barrier_complete(bar, b.x, nloc, nx); b.st[0] = nloc; b.st[1] = nx; }
        const unsigned old = xb_add(&bar[XB_XSUB(b.x)], 1u);
        const unsigned gen = old / nloc;
        if (old + 1u == (gen + 1u) * nloc) {
            __builtin_amdgcn_fence(__ATOMIC_RELEASE, "agent");
            asm volatile("s_waitcnt vmcnt(0)" ::: "memory");
            const unsigned og = xb_add(&bar[XB_TOP], 1u);
            const unsigned tg = og / nx;
            if (og + 1u == (tg + 1u) * nx) xb_add(&bar[XB_TOPGEN], 1u);
            else XB_SPIN(xb_ld(&bar[XB_TOPGEN]) == tg, bar);
            __builtin_amdgcn_fence(__ATOMIC_ACQUIRE, "agent");
            xb_add(&bar[XB_XGEN(b.x)], 1u);
            asm volatile("s_waitcnt vmcnt(0)" ::: "memory");
        } else {
            XB_SPIN(xb_ld(&bar[XB_XGEN(b.x)]) == gen, bar);
            __builtin_amdgcn_fence(__ATOMIC_ACQUIRE, "agent");
            asm volatile("s_waitcnt vmcnt(0)" ::: "memory");
        }
    }
    __syncthreads();
}

constexpr int NWAVES = 8;
#ifndef MK_N_LAUNCHES
#define MK_N_LAUNCHES 1
#endif
constexpr int NPHASES = 16;

constexpr int D = 1024, NSEQ = 136, MPR = 16384, M = 16896, MEXT = 17024, MPAD = 17152;
constexpr int NIN = 4096;
constexpr int FF = 2816, NFI = 5632, NMOD = 6144, DEPTH = 2;
constexpr int P_GQKV = 1280, P_GZ = 2432, P_H = 2816, P_BETA = 3840, P_APRE = 3846;
constexpr size_t O_PSHIFT = 17301504, O_PRWKV = 17317888, O_PCONV = 17711104, O_PGDN = 17766400, O_PHGRN = 18159616,
                 O_SSHIFT = 18421760, O_SRWKV = 18683904, O_SCONV = 24975360, O_SGDN = 25860096, O_SHGRN = 32151552, O_TOTAL = 36345856;
constexpr size_t MiB = 1u << 20;
constexpr size_t WS_CTL = 0, CTL_ZERO_BYTES = 64 * 1024;
constexpr size_t WS_MOD = 1 * MiB;
constexpr size_t WS_WIN = 8 * MiB;
constexpr size_t WS_WOUT = 24 * MiB;
constexpr size_t WS_WFI = 28 * MiB;
constexpr size_t WS_WFO = 50 * MiB;
constexpr size_t WS_HB = 62 * MiB;
constexpr size_t WS_P = 96 * MiB;
constexpr size_t WS_END = 230 * MiB;
static_assert(WS_MOD + (size_t)DEPTH * NSEQ * NMOD * 4 <= WS_WIN && WS_WIN + (size_t)DEPTH * NIN * D * 2 <= WS_WOUT && WS_WOUT + (size_t)DEPTH * D * D * 2 <= WS_WFI &&
              WS_WFI + (size_t)DEPTH * NFI * D * 2 <= WS_WFO && WS_WFO + (size_t)DEPTH * D * FF * 2 <= WS_HB && WS_HB + (size_t)MPAD * D * 2 <= WS_P && WS_P + (size_t)MPAD * NIN * 2 <= WS_END, "ws map");
constexpr int CW_BAR = 4096;
constexpr int RING_BYTES = 131072, LDSCTL_OFF = RING_BYTES, MISC_OFF = LDSCTL_OFF + 320, LDS_BYTES = 147456;

typedef LAS float lf32;
struct Args { const float* in[35]; float* out; unsigned char* ws; int ph_lo, ph_hi; };
#define INP(i) (A.in[i])
struct Frame {
    LAS unsigned char* lds;
    volatile LAS unsigned* MISC;
    gu32* ctl;
    int tid, lane, wave, G, bid;
    float* out;
    float* mod; bf16 *win_t, *wout_t, *wfi_t, *wfo_t, *hb, *p;
};
enum { I_XP = 0, I_XS, I_CP, I_CS, I_SSHIFT, I_SRWKV, I_SCONV, I_SGDN, I_SHGRN, I_WADA, I_BADA, I_NMW, I_WIN, I_MU, I_W0, I_W2, I_A0, I_A2, I_G2, I_KK, I_KA, I_RK, I_LNW, I_LNB,
       I_CONVW, I_ALOG, I_DTB, I_GNW, I_LBL, I_HNW, I_WOUT, I_NFW, I_WFI, I_WFO, I_FNW };

__device__ __forceinline__ float wave_sum(float v) {
#pragma unroll
    for (int o = 1; o < 64; o <<= 1) v += __shfl_xor(v, o);
    return v;
}
template <int CTRL> __device__ __forceinline__ float dpp_mov(float x) { return __builtin_bit_cast(float, __builtin_amdgcn_mov_dpp(__builtin_bit_cast(int, x), CTRL, 0xF, 0xF, true)); }
__device__ __forceinline__ float red8(float x) {
    x += dpp_mov<0xB1>(x);
    x += dpp_mov<0x4E>(x);
    x += dpp_mov<0x141>(x);
    return x;
}
__device__ __forceinline__ float bf2f(bf16 u) { return __builtin_bit_cast(float, (unsigned)u << 16); }
__device__ __forceinline__ float sigmoidf_(float x) { return 1.f / (1.f + __expf(-x)); }
__device__ __forceinline__ float siluf_(float x) { return x / (1.f + __expf(-x)); }
__device__ __forceinline__ float softplusf_(float x) { return fmaxf(x, 0.f) + log1pf(__expf(-fabsf(x))); }
__device__ __forceinline__ int seq_of_row(int row) { return row < MPR ? (row >> 11) : 8 + ((row - MPR) >> 2); }

__device__ __forceinline__ void transpose_item(const float* W, int ldw, int K, int k0, int src_c0, int ncv, bf16* WT, int dst_r0, lf32* scr, int lane) {
    const int c = lane & 31;
#pragma unroll 8
    for (int i = 0; i < 32; ++i) { const int kk = 2 * i + (lane >> 5); scr[kk * 33 + c] = (c < ncv) ? W[(size_t)(k0 + kk) * ldw + src_c0 + c] : 0.f; }
    LDS_WAIT(); asm volatile("" ::: "memory");
    const int c8 = lane & 7;
#pragma unroll
    for (int j = 0; j < 4; ++j) { const int n = (lane >> 3) + 8 * j; const lf32* s = scr + (8 * c8) * 33 + n;
        v4u o; o.x = pk2(s[0 * 33], s[1 * 33]); o.y = pk2(s[2 * 33], s[3 * 33]); o.z = pk2(s[4 * 33], s[5 * 33]); o.w = pk2(s[6 * 33], s[7 * 33]);
        if (n < ncv) *(GAS v4u*)(WT + (size_t)(dst_r0 + n) * K + k0 + 8 * c8) = o; }
    LDS_WAIT(); asm volatile("" ::: "memory");
}

__device__ __forceinline__ void p0_prologue(const Args& A, Frame& F) {
    {
        lf32* cact = (lf32*)F.lds;
        for (int wb = F.bid; wb < 256; wb += F.G) {
            const int l = wb >> 7, n0 = (wb & 127) * 48;
            const int ncol = n0 + (F.lane < 48 ? F.lane : 47);
            const float* Wl = INP(I_WADA) + (size_t)l * D * NMOD + ncol;
            float acc[17];
#pragma unroll
            for (int j = 0; j < 17; ++j) acc[j] = 0.f;
            for (int kc = 0; kc < 16; ++kc) {
                __syncthreads();
#pragma unroll
                for (int i = 0; i < 17; ++i) { const int idx = F.tid + 512 * i; const int s = idx >> 6, kk = idx & 63;
                    const float cv = s < 8 ? INP(I_CP)[s * D + kc * 64 + kk] : INP(I_CS)[(s - 8) * D + kc * 64 + kk];
                    cact[idx] = siluf_(cv); }
                __syncthreads();
#pragma unroll 4
                for (int kk = 0; kk < 64; ++kk) { const float wv = Wl[(size_t)(kc * 64 + kk) * NMOD];
#pragma unroll
                    for (int j = 0; j < 17; ++j) acc[j] += cact[(F.wave + 8 * j) * 64 + kk] * wv; }
            }
            if (F.lane < 48) { const float bv = INP(I_BADA)[l * NMOD + ncol];
#pragma unroll
                for (int j = 0; j < 17; ++j) F.mod[((size_t)l * NSEQ + F.wave + 8 * j) * NMOD + ncol] = acc[j] + bv; }
        }
        __syncthreads();
    }
    lf32* scr = (lf32*)(F.lds + F.wave * 16384);
    const int gw = F.bid * NWAVES + F.wave, NGW = F.G * NWAVES;
    constexpr int IT_IN = 121 * 16, IT_OUT = 32 * 16, IT_FI = 176 * 16, IT_FO = 32 * 44, IT_L = IT_IN + IT_OUT + IT_FI + IT_FO;
    for (int it = gw; it < DEPTH * IT_L; it += NGW) {
        const int l = it / IT_L; int r = it - l * IT_L;
        if (r < IT_IN) { const int nb = r >> 4, kb = r & 15;
            const int src = nb < 76 ? nb * 32 : nb < 88 ? 2444 + (nb - 76) * 32 : nb < 120 ? 2828 + (nb - 88) * 32 : 2432;
            transpose_item(INP(I_WIN) + (size_t)l * D * 3852, 3852, D, kb * 64, src, nb == 120 ? 12 : 32, F.win_t + (size_t)l * NIN * D, nb * 32, scr, F.lane); continue; }
        r -= IT_IN;
        if (r < IT_OUT) { const int nb = r >> 4, kb = r & 15;
            transpose_item(INP(I_WOUT) + (size_t)l * D * D, D, D, kb * 64, nb * 32, 32, F.wout_t + (size_t)l * D * D, nb * 32, scr, F.lane); continue; }
        r -= IT_OUT;
        if (r < IT_FI) { const int nb = r >> 4, kb = r & 15; const int pn = nb >> 3, bj = (nb >> 2) & 1, ib = nb & 3;
            transpose_item(INP(I_WFI) + (size_t)l * D * NFI, NFI, D, kb * 64, bj * FF + 128 * pn + 32 * ib, 32, F.wfi_t + (size_t)l * NFI * D, nb * 32, scr, F.lane); continue; }
        r -= IT_FI;
        { const int nb = r / 44, kb = r - nb * 44;
            transpose_item(INP(I_WFO) + (size_t)l * FF * D, D, FF, kb * 64, nb * 32, 32, F.wfo_t + (size_t)l * D * FF, nb * 32, scr, F.lane); }
    }
}

__device__ __forceinline__ void norm_phase(const Args& A, Frame& F, int l, int which) {
    const int gw = F.bid * NWAVES + F.wave, NGW = F.G * NWAVES;
    float* xres = F.out;
    const int nrows = which == 0 ? MEXT : M;
    for (int row = gw; row < nrows; row += NGW) {
        if (row >= M) {
            const GAS f32x4* sr = (const GAS f32x4*)(INP(I_SSHIFT) + ((size_t)l * 128 + (row - M)) * D) + F.lane;
            GAS unsigned long long* o8 = (GAS unsigned long long*)(F.hb + (size_t)row * D) + F.lane;
#pragma unroll
            for (int j = 0; j < 4; ++j) { const f32x4 v = sr[64 * j]; o8[64 * j] = (unsigned long long)pk2(v.x, v.y) | ((unsigned long long)pk2(v.z, v.w) << 32); }
            continue;
        }
        const float* xrow = (which == 0 && l == 0) ? (row < MPR ? INP(I_XP) + (size_t)row * D : INP(I_XS) + (size_t)(row - MPR) * D) : xres + (size_t)row * D;
        const GAS f32x4* xr = (const GAS f32x4*)xrow + F.lane;
        f32x4 v[4]; float ss = 0.f;
#pragma unroll
        for (int j = 0; j < 4; ++j) { v[j] = xr[64 * j]; ss += (v[j].x * v[j].x + v[j].y * v[j].y) + (v[j].z * v[j].z + v[j].w * v[j].w); }
        const float rstd = 1.f / sqrtf(wave_sum(ss) * (1.f / D) + 1e-6f);
        if (which == 2) {
            const GAS f32x4* wr = (const GAS f32x4*)INP(I_FNW) + F.lane;
            GAS f32x4* o = (GAS f32x4*)(xres + (size_t)row * D) + F.lane;
#pragma unroll
            for (int j = 0; j < 4; ++j) o[64 * j] = v[j] * rstd * wr[64 * j];
            continue;
        }
        const int seq = seq_of_row(row);
        const float* mrow = F.mod + ((size_t)l * NSEQ + seq) * NMOD + (which ? 3072 : 0);
        const GAS f32x4* shp = (const GAS f32x4*)mrow + F.lane;
        const GAS f32x4* scp = (const GAS f32x4*)(mrow + 1024) + F.lane;
        const GAS f32x4* wr = (const GAS f32x4*)((which ? INP(I_NFW) : INP(I_NMW)) + (size_t)l * D) + F.lane;
        const bool last = which == 0 && (row < MPR ? (row & 2047) == 2047 : ((row - MPR) & 3) == 3);
        float* so = nullptr;
        if (last) so = F.out + (row < MPR ? O_PSHIFT + ((size_t)l * 8 + (row >> 11)) * D : O_SSHIFT + ((size_t)l * 128 + ((row - MPR) >> 2)) * D);
        GAS unsigned long long* o8 = (GAS unsigned long long*)(F.hb + (size_t)row * D) + F.lane;
#pragma unroll
        for (int j = 0; j < 4; ++j) {
            const f32x4 hv = (v[j] * rstd * wr[64 * j]) * (scp[64 * j] + 1.f) + shp[64 * j];
            o8[64 * j] = (unsigned long long)pk2(hv.x, hv.y) | ((unsigned long long)pk2(hv.z, hv.w) << 32);
            if (last) ((GAS f32x4*)so + F.lane)[64 * j] = hv;
        }
    }
}

constexpr int TC = 32;
__device__ __forceinline__ void ld8(const lf32* p, float (&v)[8]) { const f32x4 a = *(const LAS f32x4*)p, b = *(const LAS f32x4*)(p + 4); v[0] = a.x; v[1] = a.y; v[2] = a.z; v[3] = a.w; v[4] = b.x; v[5] = b.y; v[6] = b.z; v[7] = b.w; }

__device__ __forceinline__ void rwkv_job(const Args& A, Frame& F, int l, int s, int h) {
    lf32* L = (lf32*)F.lds;
    lf32 *XL = L, *SA = L + 4096, *SD = L + 6144, *SB = L + 8192, *SK = L + 10240, *SDR = L + 12288, *SV = L + 14336, *SG = L + 16384, *SO = L + 18432, *SC = L + 20480,
         *W2 = L + 20608, *A2 = L + 22656, *G2 = L + 24704, *PRM = L + 28800, *MU = L + 29248;
    const int T = s < 8 ? 2048 : 4; const int row0 = s < 8 ? s * 2048 : MPR + (s - 8) * 4;
    const int tid = F.tid, lane = F.lane, wave = F.wave;
    __syncthreads();
    for (int i = tid; i < 2048; i += 512) { const int r = i >> 6, j = i & 63;
        W2[i] = INP(I_W2)[((size_t)l * 32 + r) * 384 + h * 64 + j]; A2[i] = INP(I_A2)[((size_t)l * 32 + r) * 384 + h * 64 + j]; }
    for (int i = tid; i < 4096; i += 512) { const int r = i >> 6, j = i & 63; G2[i] = INP(I_G2)[((size_t)l * 64 + r) * 384 + h * 64 + j]; }
    if (tid < 64) { const int c = l * 384 + h * 64 + tid;
        PRM[tid] = INP(I_W0)[c]; PRM[64 + tid] = INP(I_A0)[c]; PRM[128 + tid] = INP(I_KK)[c]; PRM[192 + tid] = INP(I_KA)[c]; PRM[256 + tid] = INP(I_RK)[c]; PRM[320 + tid] = INP(I_LNW)[c]; PRM[384 + tid] = INP(I_LNB)[c]; }
    if (tid < 320) { const int c = tid < 192 ? (tid >> 6) * 384 + h * 64 + (tid & 63) : 1152 + (tid - 192); MU[tid] = INP(I_MU)[l * 1280 + c]; }
    const int col = tid >> 3, ks = tid & 7;
    float st[8];
    float* sout = F.out + (s < 8 ? O_PRWKV + (((size_t)l * 8 + s) * 6 + h) * 4096 : O_SRWKV + (((size_t)l * 128 + (s - 8)) * 6 + h) * 4096) + col * 64 + ks * 8;
    if (s < 8) {
#pragma unroll
        for (int j = 0; j < 8; ++j) st[j] = 0.f;
    } else { const float* sp = INP(I_SRWKV) + (((size_t)l * 128 + (s - 8)) * 6 + h) * 4096 + col * 64 + ks * 8;
        const f32x4 a = *(const f32x4*)sp, b = *(const f32x4*)(sp + 4); st[0] = a.x; st[1] = a.y; st[2] = a.z; st[3] = a.w; st[4] = b.x; st[5] = b.y; st[6] = b.z; st[7] = b.w; }
    const bf16* P = F.p;
    const size_t prevrow = (size_t)(M + (s - 8)) * NIN;
    for (int c0 = 0; c0 < T; c0 += TC) {
        const int n = (T - c0) < TC ? (T - c0) : TC;
        __syncthreads();
        for (int idx = tid; idx < n * 128; idx += 512) { const int t = idx >> 7, i = idx & 127; const int tt = c0 + t;
            const float cur = bf2f(P[(size_t)(row0 + tt) * NIN + 1152 + i]);
            const float prv = tt > 0 ? bf2f(P[(size_t)(row0 + tt - 1) * NIN + 1152 + i]) : (s < 8 ? 0.f : bf2f(P[prevrow + 1152 + i]));
            const float xs = cur + MU[192 + i] * (prv - cur);
            XL[idx] = i < 32 ? tanhf(xs) : i < 64 ? xs : sigmoidf_(xs); }
        __syncthreads();
        for (int t = wave; t < n; t += 8) { const int tt = c0 + t; const size_t rb = (size_t)(row0 + tt) * NIN + h * 64 + lane;
            float cr = bf2f(P[rb]), ck = bf2f(P[rb + 384]), cv = bf2f(P[rb + 768]); float pr, pk, pv;
            if (tt > 0) { pr = bf2f(P[rb - NIN]); pk = bf2f(P[rb - NIN + 384]); pv = bf2f(P[rb - NIN + 768]); }
            else if (s >= 8) { const size_t pb = prevrow + h * 64 + lane; pr = bf2f(P[pb]); pk = bf2f(P[pb + 384]); pv = bf2f(P[pb + 768]); }
            else { pr = 0.f; pk = 0.f; pv = 0.f; }
            const float r = cr + MU[lane] * (pr - cr), k = ck + MU[64 + lane] * (pk - ck), v = cv + MU[128 + lane] * (pv - cv);
            float wp = PRM[lane], ap = PRM[64 + lane], g = 0.f;
            const lf32* xl = XL + t * 128;
#pragma unroll 8
            for (int i = 0; i < 32; ++i) { wp += xl[i] * W2[i * 64 + lane]; ap += xl[32 + i] * A2[i * 64 + lane]; }
#pragma unroll 8
            for (int i = 0; i < 64; ++i) g += xl[64 + i] * G2[i * 64 + lane];
            const float w = -softplusf_(-wp) - 0.5f; const float d = __expf(-__expf(w)); const float alr = sigmoidf_(ap);
            const float kkr = k * PRM[128 + lane]; const float kk = kkr * (1.f / sqrtf(wave_sum(kkr * kkr) + 1e-6f));
            const float kp = k * (1.f + (alr - 1.f) * PRM[192 + lane]);
            const float b = kk * alr;
            const float br = wave_sum(b * r), kr = wave_sum(kp * r), bc = wave_sum(r * kp * PRM[256 + lane]);
            const int o = t * 64 + lane;
            SA[o] = -kk; SD[o] = d; SB[o] = b; SK[o] = kp; SDR[o] = d * r; SV[o] = v; SG[o] = g;
            if (lane == 0) { SC[t * 4] = br; SC[t * 4 + 1] = kr; SC[t * 4 + 2] = bc; }
        }
        __syncthreads();
        for (int t = 0; t < n; ++t) {
            float a8[8], q8[8]; ld8(SA + t * 64 + ks * 8, a8); ld8(SDR + t * 64 + ks * 8, q8);
            float p1 = 0.f, p2 = 0.f;
#pragma unroll
            for (int j = 0; j < 8; ++j) { p1 += st[j] * a8[j]; p2 += st[j] * q8[j]; }
            p1 = red8(p1); p2 = red8(p2);
            float d8[8], b8[8], k8[8]; ld8(SD + t * 64 + ks * 8, d8); ld8(SB + t * 64 + ks * 8, b8); ld8(SK + t * 64 + ks * 8, k8);
            const float vv = SV[t * 64 + col]; const float br = SC[t * 4], kr = SC[t * 4 + 1];
#pragma unroll
            for (int j = 0; j < 8; ++j) st[j] = st[j] * d8[j] + (p1 * b8[j] + vv * k8[j]);
            if (ks == 0) SO[t * 64 + col] = p2 + p1 * br + vv * kr;
        }
        __syncthreads();
        for (int t = wave; t < n; t += 8) { const int o = t * 64 + lane;
            const float y = SO[o]; const float mu = wave_sum(y) * (1.f / 64.f); const float dv = y - mu; const float var = wave_sum(dv * dv) * (1.f / 64.f);
            const float yn = dv * (1.f / sqrtf(var + 64e-5f)) * PRM[320 + lane] + PRM[384 + lane];
            const float res = (yn + SC[t * 4 + 2] * SV[o]) * SG[o];
            F.hb[(size_t)(row0 + c0 + t) * D + h * 64 + lane] = (bf16)f2bf(res); }
    }
    { f32x4 a = {st[0], st[1], st[2], st[3]}, b = {st[4], st[5], st[6], st[7]}; *(f32x4*)sout = a; *(f32x4*)(sout + 4) = b; }
}

__device__ __forceinline__ void gdn_job(const Args& A, Frame& F, int l, int s, int h) {
    lf32* L = (lf32*)F.lds;
    lf32 *SKn = L, *SQn = L + 2048, *SV = L + 4096, *SZ = L + 6144, *SO = L + 8192, *SC = L + 10240, *CW = L + 10368, *NW = L + 11136, *ST = L + 11264;
    const int T = s < 8 ? 2048 : 4; const int row0 = s < 8 ? s * 2048 : MPR + (s - 8) * 4;
    const int tid = F.tid, lane = F.lane, wave = F.wave;
    __syncthreads();
    for (int i = tid; i < 768; i += 512) { const int jj = i / 192, r = i - jj * 192; const int ch = r >> 6, j = r & 63; CW[i] = INP(I_CONVW)[((size_t)l * 4 + jj) * 1152 + ch * 384 + h * 64 + j]; }
    if (tid < 64) NW[tid] = INP(I_GNW)[l * 64 + tid];
    const float Aneg = -__expf(INP(I_ALOG)[l * 6 + h]); const float dtb = INP(I_DTB)[l * 6 + h];
    const int col = tid >> 3, ks = tid & 7;
    float st[8];
    float* sout = F.out + (s < 8 ? O_PGDN + (((size_t)l * 8 + s) * 6 + h) * 4096 : O_SGDN + (((size_t)l * 128 + (s - 8)) * 6 + h) * 4096);
    if (s < 8) {
#pragma unroll
        for (int j = 0; j < 8; ++j) st[j] = 0.f;
    } else { const float* sp = INP(I_SGDN) + (((size_t)l * 128 + (s - 8)) * 6 + h) * 4096;
        for (int i = tid; i < 4096; i += 512) ST[(i >> 6) * 65 + (i & 63)] = sp[i];
        __syncthreads();
#pragma unroll
        for (int j = 0; j < 8; ++j) st[j] = ST[(ks * 8 + j) * 65 + col]; }
    const bf16* P = F.p;
    const float* cbuf = INP(I_SCONV) + ((size_t)l * 128 + (s - 8)) * 3 * 1152;
    for (int c0 = 0; c0 < T; c0 += TC) {
        const int n = (T - c0) < TC ? (T - c0) : TC;
        __syncthreads();
        for (int t = wave; t < n; t += 8) { const int tt = c0 + t; const size_t rb = (size_t)(row0 + tt) * NIN;
            float val[3];
#pragma unroll
            for (int ch = 0; ch < 3; ++ch) { float acc = 0.f;
#pragma unroll
                for (int jj = 0; jj < 4; ++jj) { const int tau = tt - 3 + jj;
                    float x;
                    if (tau >= 0) x = bf2f(P[(size_t)(row0 + tau) * NIN + P_GQKV + ch * 384 + h * 64 + lane]);
                    else x = s < 8 ? 0.f : cbuf[(3 + tau) * 1152 + ch * 384 + h * 64 + lane];
                    acc += CW[(jj * 3 + ch) * 64 + lane] * x; }
                val[ch] = siluf_(acc); }
            const float qn = val[0] * (1.f / sqrtf(wave_sum(val[0] * val[0]) + 1e-6f)) * 0.125f;
            const float kn = val[1] * (1.f / sqrtf(wave_sum(val[1] * val[1]) + 1e-6f));
            const float kq = wave_sum(kn * qn);
            const int o = t * 64 + lane;
            SKn[o] = kn; SQn[o] = qn; SV[o] = val[2]; SZ[o] = bf2f(P[rb + P_GZ + h * 64 + lane]);
            if (lane == 0) { const float beta = sigmoidf_(bf2f(P[rb + P_BETA + h])); const float g = Aneg * softplusf_(bf2f(P[rb + P_APRE + h]) + dtb);
                SC[t * 4] = __expf(g); SC[t * 4 + 1] = beta; SC[t * 4 + 2] = kq; }
        }
        __syncthreads();
        for (int t = 0; t < n; ++t) {
            float k8[8], q8[8]; ld8(SKn + t * 64 + ks * 8, k8); ld8(SQn + t * 64 + ks * 8, q8);
            float p1 = 0.f, p2 = 0.f;
#pragma unroll
            for (int j = 0; j < 8; ++j) { p1 += st[j] * k8[j]; p2 += st[j] * q8[j]; }
            p1 = red8(p1); p2 = red8(p2);
            const float eg = SC[t * 4], beta = SC[t * 4 + 1], kq = SC[t * 4 + 2];
            const float vnew = beta * (SV[t * 64 + col] - eg * p1);
#pragma unroll
            for (int j = 0; j < 8; ++j) st[j] = st[j] * eg + k8[j] * vnew;
            if (ks == 0) SO[t * 64 + col] = eg * p2 + vnew * kq;
        }
        __syncthreads();
        for (int t = wave; t < n; t += 8) { const int o = t * 64 + lane;
            const float y = SO[o]; const float ms = wave_sum(y * y) * (1.f / 64.f);
            const float res = y * (1.f / sqrtf(ms + 1e-6f)) * NW[lane] * siluf_(SZ[o]);
            F.hb[(size_t)(row0 + c0 + t) * D + 384 + h * 64 + lane] = (bf16)f2bf(res); }
    }
    __syncthreads();
#pragma unroll
    for (int j = 0; j < 8; ++j) ST[(ks * 8 + j) * 65 + col] = st[j];
    __syncthreads();
    for (int i = tid; i < 4096; i += 512) sout[i] = ST[(i >> 6) * 65 + (i & 63)];
    if (tid < 192) { const int ch = tid >> 6, j = tid & 63;
        float* co = F.out + (s < 8 ? O_PCONV + ((size_t)l * 8 + s) * 3 * 1152 : O_SCONV + ((size_t)l * 128 + (s - 8)) * 3 * 1152) + ch * 384 + h * 64 + j;
#pragma unroll
        for (int i = 0; i < 3; ++i) { const int tau = T - 3 + i;
            co[i * 1152] = tau >= 0 ? bf2f(P[(size_t)(row0 + tau) * NIN + P_GQKV + ch * 384 + h * 64 + j]) : (s < 8 ? 0.f : cbuf[(3 + tau) * 1152 + ch * 384 + h * 64 + j]); } }
}

__device__ __forceinline__ void hgrn_job(const Args& A, Frame& F, int l, int s, int h) {
    lf32* L = (lf32*)F.lds;
    lf32 *SF = L, *SKK = L + 2048, *SQ = L + 4096, *SI = L + 6144, *SZ = L + 8192, *SO = L + 10240, *NW = L + 12288, *ST = L + 12416;
    const int T = s < 8 ? 2048 : 4; const int row0 = s < 8 ? s * 2048 : MPR + (s - 8) * 4;
    const int tid = F.tid, lane = F.lane, wave = F.wave;
    __syncthreads();
    if (tid < 64) NW[tid] = INP(I_HNW)[l * 64 + tid];
    float lb = 0.f;
    if (l == 1) { const float l0 = INP(I_LBL)[h * 64 + lane], l1 = INP(I_LBL)[256 + h * 64 + lane]; lb = 1.f / (1.f + __expf(l0 - l1)); }
    const int col = tid >> 3, ks = tid & 7;
    float st[8];
    float* sout = F.out + (s < 8 ? O_PHGRN + (((size_t)l * 8 + s) * 4 + h) * 4096 : O_SHGRN + (((size_t)l * 128 + (s - 8)) * 4 + h) * 4096);
    if (s < 8) {
#pragma unroll
        for (int j = 0; j < 8; ++j) st[j] = 0.f;
    } else { const float* sp = INP(I_SHGRN) + (((size_t)l * 128 + (s - 8)) * 4 + h) * 4096;
        for (int i = tid; i < 4096; i += 512) ST[(i >> 6) * 65 + (i & 63)] = sp[i];
        __syncthreads();
#pragma unroll
        for (int j = 0; j < 8; ++j) st[j] = ST[(ks * 8 + j) * 65 + col]; }
    const bf16* P = F.p;
    for (int c0 = 0; c0 < T; c0 += TC) {
        const int n = (T - c0) < TC ? (T - c0) : TC;
        __syncthreads();
        for (int t = wave; t < n; t += 8) { const size_t rb = (size_t)(row0 + c0 + t) * NIN + P_H + h * 64 + lane;
            const float q = bf2f(P[rb]), f = bf2f(P[rb + 256]), iv = bf2f(P[rb + 512]), z = bf2f(P[rb + 768]);
            const float sg = sigmoidf_(f), sgn = 1.f / (1.f + __expf(f));
            const int o = t * 64 + lane;
            SF[o] = lb + (1.f - lb) * sg; SKK[o] = (1.f - lb) * sgn; SQ[o] = siluf_(q); SI[o] = iv; SZ[o] = z; }
        __syncthreads();
        for (int t = 0; t < n; ++t) {
            float f8[8], k8[8], q8[8]; ld8(SF + t * 64 + ks * 8, f8); ld8(SKK + t * 64 + ks * 8, k8); ld8(SQ + t * 64 + ks * 8, q8);
            const float iv = SI[t * 64 + col];
            float p = 0.f;
#pragma unroll
            for (int j = 0; j < 8; ++j) { st[j] = st[j] * f8[j] + k8[j] * iv; p += q8[j] * st[j]; }
            p = red8(p);
            if (ks == 0) SO[t * 64 + col] = p;
        }
        __syncthreads();
        for (int t = wave; t < n; t += 8) { const int o = t * 64 + lane;
            const float y = SO[o]; const float ms = wave_sum(y * y) * (1.f / 64.f);
            const float res = y * (1.f / sqrtf(ms + 1e-6f)) * NW[lane] * sigmoidf_(SZ[o]);
            F.hb[(size_t)(row0 + c0 + t) * D + 768 + h * 64 + lane] = (bf16)f2bf(res); }
    }
    __syncthreads();
#pragma unroll
    for (int j = 0; j < 8; ++j) ST[(ks * 8 + j) * 65 + col] = st[j];
    __syncthreads();
    for (int i = tid; i < 4096; i += 512) sout[i] = ST[(i >> 6) * 65 + (i & 63)];
}

__device__ __forceinline__ void run_job(const Args& A, Frame& F, int l, int s, int hh) {
    if (hh < 6) rwkv_job(A, F, l, s, hh); else if (hh < 12) gdn_job(A, F, l, s, hh - 6); else hgrn_job(A, F, l, s, hh - 12);
}
__device__ __forceinline__ void scan_phase(const Args& A, Frame& F, int l) {
    const bool two = F.G > 128; const int nshort_wg = two ? F.G - 128 : F.G; const int me = two ? F.bid - 128 : F.bid;
    for (int it = 0;; ++it) {
        int s, hh;
        const int jl = F.bid + it * F.G;
        if (jl < 128) { s = jl & 7; hh = jl >> 3; }
        else { const int its = two ? it : it - (128 - F.bid + F.G - 1) / F.G; const int q = me + its * nshort_wg; if (me < 0 || its < 0 || q >= 2048) break; s = 8 + (q & 127); hh = q >> 7; }
        run_job(A, F, l, s, hh);
    }
}

__global__ void __launch_bounds__(NWAVES * 64, 2) mk_fwd(Args args) {
    const Args& A = args;
    extern __shared__ __attribute__((aligned(16))) unsigned char lds[];
    Frame F;
    F.lds = (LAS unsigned char*)lds;
    F.MISC = (volatile LAS unsigned*)(F.lds + MISC_OFF);
    F.tid = threadIdx.x; F.lane = F.tid & 63; F.wave = __builtin_amdgcn_readfirstlane(F.tid >> 6);
    F.G = gridDim.x; F.bid = blockIdx.x;
    unsigned char* ws = args.ws;
    F.ctl = (gu32*)(ws + WS_CTL);
    F.out = args.out;
    F.mod = (float*)(ws + WS_MOD); F.win_t = (bf16*)(ws + WS_WIN); F.wout_t = (bf16*)(ws + WS_WOUT); F.wfi_t = (bf16*)(ws + WS_WFI); F.wfo_t = (bf16*)(ws + WS_WFO);
    F.hb = (bf16*)(ws + WS_HB); F.p = (bf16*)(ws + WS_P);
    for (int u = F.tid; u < (LDS_BYTES - LDSCTL_OFF) / 4; u += NWAVES * 64) ((LAS unsigned*)(F.lds + LDSCTL_OFF))[u] = 0u;
    __syncthreads();
    XcdBarrier bar; bar.bar = (unsigned*)(F.ctl + CW_BAR); bar.x = 0; bar.st = nullptr;
    if (MK_N_LAUNCHES == 1) bar = xcd_barrier_post((unsigned*)(F.ctl + CW_BAR), F.MISC + 8);
    const int lo = args.ph_lo, hi = args.ph_hi;
#ifndef PH_MASK
#define PH_MASK 0xFFFF
#endif

    for (int ph = lo; ph < hi; ++ph) {
        { int t_ = threadIdx.x; asm volatile("" : "+v"(t_)); F.tid = t_; F.lane = t_ & 63; F.wave = __builtin_amdgcn_readfirstlane(t_ >> 6);
          int b_ = blockIdx.x; asm volatile("" : "+s"(b_)); F.bid = b_; }
        if (!((PH_MASK >> (ph == 0 ? 0 : ph == 15 ? 8 : 1 + ((ph - 1) % 7))) & 1)) continue;
        if (ph == 0) p0_prologue(A, F);
        else if (ph == 15) norm_phase(A, F, 0, 2);
        else {
            const int l = (ph - 1) / 7, k = (ph - 1) - 7 * l;
            if (k == 0 || k == 4) norm_phase(A, F, l, k == 0 ? 0 : 1);
            else if (k == 2) scan_phase(A, F, l);
            else {
                pg8::Gemm g; pg8::EpiAny E; E.mode = (k == 1) ? 0 : (k == 5) ? 2 : 1;
                const float* x0p = (l == 0 && k == 3) ? INP(I_XP) : F.out; const float* x0s = (l == 0 && k == 3) ? INP(I_XS) : F.out + (size_t)MPR * D;
                E.xin_p = x0p; E.xin_s = x0s; E.xout = F.out; E.gate = F.mod + (size_t)l * NSEQ * NMOD + (k == 3 ? 2048 : 5120);
                E.O = F.p; E.ldc = (k == 1) ? NIN : FF;
                g.A = (k == 6) ? F.p : F.hb;
                g.Bt = (k == 1) ? F.win_t + (size_t)l * NIN * D : (k == 3) ? F.wout_t + (size_t)l * D * D : (k == 5) ? F.wfi_t + (size_t)l * NFI * D : F.wfo_t + (size_t)l * D * FF;
                g.M = (k == 1) ? MPAD : M; g.N = (k == 1) ? NIN : (k == 5) ? NFI : D; g.K = (k == 6) ? FF : D;
                pg8::StaticOrder S; S.init(g.M, g.N, F.G, F.bid);
                pg8::gemm_phase<pg8::EpiAny, pg8::StaticOrder, true, true>(F.lds, g, S, E, F.tid);
            }
        }
        if (ph + 1 < hi) xcd_barrier(bar);
    }
}

extern "C" void kernel_launch(void* const* d_in, const int* in_sizes, int n_in, void* d_out, int out_size, void* d_ws, size_t ws_size, hipStream_t stream) {
    static int grid = 0;
    if (grid == 0) {
        if (n_in != 35 || (size_t)out_size != O_TOTAL || ws_size < WS_END) { fprintf(stderr, "kernel_launch: unexpected shapes (n_in %d out %d ws %zu); nothing launched\n", n_in, out_size, ws_size); grid = -1; return; }
        int dev = 0, cus = 0, per_cu = 0;
        if (hipGetDevice(&dev) != hipSuccess || hipDeviceGetAttribute(&cus, hipDeviceAttributeMultiprocessorCount, dev) != hipSuccess) { grid = -1; return; }
        if (hipFuncSetAttribute((const void*)mk_fwd, hipFuncAttributeMaxDynamicSharedMemorySize, LDS_BYTES) != hipSuccess) { fprintf(stderr, "kernel_launch: hipFuncSetAttribute failed\n"); grid = -1; return; }
        if (hipOccupancyMaxActiveBlocksPerMultiprocessor(&per_cu, (const void*)mk_fwd, NWAVES * 64, LDS_BYTES) != hipSuccess || per_cu < 1) { fprintf(stderr, "kernel_launch: occupancy query says %d\n", per_cu); }
        (void)hipGetLastError();
        grid = cus;
    }
    if (grid < 0) return;
    (void)hipMemsetAsync((char*)d_ws + WS_CTL, 0, CTL_ZERO_BYTES, stream);
    Args a{};
    for (int i = 0; i < 35; ++i) a.in[i] = (const float*)d_in[i];
    a.out = (float*)d_out; a.ws = (unsigned char*)d_ws;
    if (MK_N_LAUNCHES == 1) { a.ph_lo = 0; a.ph_hi = NPHASES; hipLaunchKernelGGL(mk_fwd, dim3(grid), dim3(NWAVES * 64), LDS_BYTES, stream, a); }
    else for (int ph = 0; ph < NPHASES; ++ph) { a.ph_lo = ph; a.ph_hi = ph + 1; hipLaunchKernelGGL(mk_fwd, dim3(grid), dim3(NWAVES * 64), LDS_BYTES, stream, a); }
}
```
